# Optimizing an MI355X kernel written in HIP

```python
import jax, jax.numpy as jnp
from jax import lax
import numpy as np

D_MODEL = 1024
BATCH = 8
SEQ = 4096
DEPTH = 2

N_MIXERS = 2
CONV_WIDTH = 3
N_HEADS = 16
N_KV_HEADS = 4
HEAD_DIM = D_MODEL // N_HEADS
GROUP = N_HEADS // N_KV_HEADS
AXIS_DIM = HEAD_DIM // 2
ROPE_THETA = 10000.0
Q_BLOCK = 128
GRID_W = 64
N_EXPERTS = 16
CAPACITY_FACTOR = 2
D_FF_EXPERT = 2 * D_MODEL
EPS = 1e-6

N_CONV_LAYERS = (DEPTH + 1) // 2
N_ATTN_LAYERS = DEPTH // 2

kernel_name = "hybrid_conv_attn_ec_moe_encoder"


def _rms32(x, g):
    x32 = x.astype(jnp.float32)
    return x32 * lax.rsqrt(jnp.mean(x32 * x32, axis=-1, keepdims=True) + EPS) * g.astype(jnp.float32)


def rmsnorm(x, g):
    return _rms32(x, g).astype(x.dtype)


def short_gated_conv(xn, w_in, w_conv, w_out):
    bch = xn @ w_in
    b, c, h = jnp.split(bch, 3, axis=-1)
    u = c * h
    up = jnp.pad(u, ((0, 0), (1, 1), (0, 0)))
    y = w_conv[0] * up[:, :-2] + w_conv[1] * up[:, 1:-1] + w_conv[2] * up[:, 2:]
    return (b * y) @ w_out


def axial_rope_tables(seq_len):
    rows = seq_len // GRID_W
    row = jnp.repeat(jnp.arange(rows, dtype=jnp.float32), GRID_W)
    col = jnp.tile(jnp.arange(GRID_W, dtype=jnp.float32), rows)
    inv_freq = ROPE_THETA ** (-jnp.arange(0, AXIS_DIM, 2, dtype=jnp.float32) / AXIS_DIM)
    ang_r = row[:, None] * inv_freq[None, :]
    ang_c = col[:, None] * inv_freq[None, :]
    return jnp.cos(ang_r), jnp.sin(ang_r), jnp.cos(ang_c), jnp.sin(ang_c)


def _rotate(x, cos, sin):
    x1, x2 = jnp.split(x, 2, axis=-1)
    cos = cos[None, :, None, :]
    sin = sin[None, :, None, :]
    return jnp.concatenate([x1 * cos - x2 * sin, x2 * cos + x1 * sin], axis=-1)


def apply_axial_rope(x, tables):
    cr, sr, cc, sc = tables
    return jnp.concatenate([_rotate(x[..., :AXIS_DIM], cr, sr),
                            _rotate(x[..., AXIS_DIM:], cc, sc)], axis=-1)


def gqa_axial_attention(xn, w_qkv, g_q, g_k, w_o):
    bsz, seq, _ = xn.shape
    dt = xn.dtype
    qkv = xn @ w_qkv
    nq, nk = N_HEADS * HEAD_DIM, N_KV_HEADS * HEAD_DIM
    q = qkv[..., :nq].reshape(bsz, seq, N_HEADS, HEAD_DIM)
    k = qkv[..., nq:nq + nk].reshape(bsz, seq, N_KV_HEADS, HEAD_DIM)
    v = qkv[..., nq + nk:].reshape(bsz, seq, N_KV_HEADS, HEAD_DIM)
    tables = axial_rope_tables(seq)
    q = (apply_axial_rope(_rms32(q, g_q), tables) * (HEAD_DIM ** -0.5)).astype(dt)
    k = apply_axial_rope(_rms32(k, g_k), tables).astype(dt)
    n_blocks = seq // Q_BLOCK
    qb = q.reshape(bsz, n_blocks, Q_BLOCK, N_KV_HEADS, GROUP, HEAD_DIM).transpose(1, 0, 2, 3, 4, 5)

    def block(q_blk):
        s = jnp.einsum('bqkgd,bskd->bkgqs', q_blk, k).astype(jnp.float32)
        p = jax.nn.softmax(s, axis=-1).astype(v.dtype)
        return jnp.einsum('bkgqs,bskd->bqkgd', p, v)

    o = lax.map(block, qb)
    o = o.transpose(1, 0, 2, 3, 4, 5).reshape(bsz, seq, N_HEADS * HEAD_DIM)
    return o @ w_o


def expert_choice_moe(xn, w_router, w_gate, w_up, w_down):
    bsz, seq, d = xn.shape
    cap = CAPACITY_FACTOR * seq // N_EXPERTS
    logits = jnp.einsum('bsd,de->bse', xn, w_router).astype(jnp.float32)
    aff = jax.nn.softmax(logits, axis=-1)
    gate, idx = lax.top_k(aff.transpose(0, 2, 1), cap)
    xg = jax.vmap(lambda xb, ib: xb[ib])(xn, idx)
    h = jax.nn.silu(jnp.einsum('becd,edf->becf', xg, w_gate)) * jnp.einsum('becd,edf->becf', xg, w_up)
    y = jnp.einsum('becf,efd->becd', h, w_down) * gate[..., None].astype(xn.dtype)
    return jax.vmap(lambda yb, ib: jnp.zeros((seq, d), xn.dtype).at[ib.reshape(-1)].add(yb.reshape(-1, d)))(y, idx)


def setup_inputs(seed: int = 0) -> dict:
    key = jax.random.key(seed)
    ks = jax.random.split(key, 16)
    D, E, F = D_MODEL, N_EXPERTS, D_FF_EXPERT
    nqkv = (N_HEADS + 2 * N_KV_HEADS) * HEAD_DIM
    nrm = lambda k, shape, s: jax.random.normal(k, shape, jnp.float32) * s
    return {
        "x": nrm(ks[0], (BATCH, SEQ, D), 1.0),
        "norm_mix": 1.0 + nrm(ks[1], (DEPTH, D), 0.02),
        "norm_ffn": 1.0 + nrm(ks[2], (DEPTH, D), 0.02),
        "conv_in": nrm(ks[3], (N_CONV_LAYERS, D, 3 * D), D ** -0.5),
        "conv_w": nrm(ks[4], (N_CONV_LAYERS, CONV_WIDTH, D), CONV_WIDTH ** -0.5),
        "conv_out": nrm(ks[5], (N_CONV_LAYERS, D, D), D ** -0.5),
        "attn_qkv": nrm(ks[6], (N_ATTN_LAYERS, D, nqkv), D ** -0.5),
        "attn_q_norm": 1.0 + nrm(ks[7], (N_ATTN_LAYERS, HEAD_DIM), 0.02),
        "attn_k_norm": 1.0 + nrm(ks[8], (N_ATTN_LAYERS, HEAD_DIM), 0.02),
        "attn_out": nrm(ks[9], (N_ATTN_LAYERS, N_HEADS * HEAD_DIM, D), D ** -0.5),
        "router": nrm(ks[10], (DEPTH, D, E), D ** -0.5),
        "w_gate": nrm(ks[11], (DEPTH, E, D, F), D ** -0.5),
        "w_up": nrm(ks[12], (DEPTH, E, D, F), D ** -0.5),
        "w_down": nrm(ks[13], (DEPTH, E, F, D), F ** -0.5),
        "final_norm": 1.0 + nrm(ks[14], (D,), 0.02),
    }


def reference(x, norm_mix, norm_ffn, conv_in, conv_w, conv_out, attn_qkv, attn_q_norm,
              attn_k_norm, attn_out, router, w_gate, w_up, w_down, final_norm):
    h = x
    for i in range(DEPTH):
        xn = rmsnorm(h, norm_mix[i])
        j = i // N_MIXERS
        if i % N_MIXERS == 0:
            h = h + short_gated_conv(xn, conv_in[j], conv_w[j], conv_out[j])
        else:
            h = h + gqa_axial_attention(xn, attn_qkv[j], attn_q_norm[j], attn_k_norm[j], attn_out[j])
        xn = rmsnorm(h, norm_ffn[i])
        h = h + expert_choice_moe(xn, router[i], w_gate[i], w_up[i], w_down[i])
    return rmsnorm(h, final_norm)
```

```cpp
#include <hip/hip_runtime.h>
#include <hip/hip_bf16.h>
#include <cstdio>
#include <cstdint>
#include <cmath>

#ifndef MOE_FP8
#define MOE_FP8 1
#endif
#ifndef ATTN_FP8
#ifndef P0_REP
#define P0_REP 0
#endif
#ifndef P1_CONV
#define P1_CONV 64
#endif
#define P10_PANELS 2432
#define P10_HELP 3
#define P1_ALL 1
#define P1_SPLIT 24576
#define ATTN_SIDE 0
#define ATTN_FP8 1
#endif
#ifndef KREP_MOE1
#define KREP_MOE1 1
#endif
#ifndef KREP_P1
#define KREP_P1 1
#endif
#ifndef MK_N_LAUNCHES
#define MK_N_LAUNCHES 1
#endif

namespace pg8 {
#define PG8_LAS __attribute__((address_space(3)))
typedef unsigned short bf16_t;
typedef short bf16x8 __attribute__((ext_vector_type(8)));
typedef float f32x4 __attribute__((ext_vector_type(4)));
typedef unsigned u32x4 __attribute__((ext_vector_type(4)));
typedef int i32x4 __attribute__((ext_vector_type(4)));
typedef int i32x8 __attribute__((ext_vector_type(8)));
constexpr int BM = 256, BK = 64, HALF = 128, HTB = HALF * BK * 2  , STAGE_BYTES = 8 * HTB, NXCD = 8, WGM = 8;

__host__ __device__ __forceinline__ int lds_byte(int r, int c) { const int st = (r >> 4) * 2 + (c >> 5), rr = r & 15, cc = c & 31, ob = rr * 64 + cc * 2; return st * 1024 + (ob ^ (((ob >> 9) & 1) << 5)); }
__host__ __device__ __forceinline__ void stage_rc(int b, int& R, int& C) { const int st = b / 1024, sb = b % 1024, swz = sb ^ (((sb >> 9) & 1) << 5); R = (st >> 1) * 16 + swz / 64; C = (st & 1) * 32 + (swz % 64) / 2; }
__host__ __device__ __forceinline__ int perm32(int rho) { const int n = rho >> 4, i = rho & 15; return 8 * (i >> 2) + 4 * n + (i & 3); }

struct Unit { int pm, pn, bt, ui; };
struct Gemm { const void* A; const void* Bt; int K; const PG8_LAS unsigned* gidx; int sa, sb, sb1; };

struct StaticOrder {
    int nM, nN, nwg, G, c;
    __host__ __device__ __forceinline__ void init(int M, int N, int G_, int c_) { nM = M / BM; nN = N / BM; nwg = nM * nN; G = G_; c = c_; }
    __host__ __device__ __forceinline__ bool next(int i, Unit& u) const {
        const long L = (long)i * G + c; if (L >= nwg) return false;
        int wgid = (int)L; { const int q = nwg / NXCD, r = nwg % NXCD, xcd = wgid % NXCD, off = wgid / NXCD; wgid = (xcd < r ? xcd * (q + 1) : r * (q + 1) + (xcd - r) * q) + off; }
        const int nig = WGM * nN, gid = wgid / nig, fm = gid * WGM, gsz = (nM - fm) < WGM ? (nM - fm) : WGM;
        u.pm = fm + ((wgid % nig) % gsz); u.pn = (wgid % nig) / gsz; u.bt = u.pn; u.ui = i; return true;
    }
};
struct Moe1Order {
    int G, c;
    __device__ __forceinline__ bool next(int i, Unit& u) const {
        const int L = i * G + c; if (L >= 4096) return false;
        const int ip = L >> 9, sub = (L >> 8) & 1, w = L & 255, x = w >> 5, l = w & 31;
        const int e = 2 * ip + (x & 1), rt = 4 * (x >> 1) + (l >> 3), pn = 2 * (l & 7) + sub;
        u.pm = e * 16 + rt; u.pn = pn; u.bt = e * 16 + pn; u.ui = i; return true;
    }
};
struct Moe2Order {
    int G, c;
    __device__ __forceinline__ bool next(int i, Unit& u) const {
        const int L = i * G + c; if (L >= 1024) return false;
        const int r4 = L >> 8, w = L & 255, x = w >> 5, l = w & 31;
        const int e = 4 * r4 + (x >> 1), rt = 8 * (x & 1) + (l >> 2), pn = l & 3;
        u.pm = e * 16 + rt; u.pn = pn; u.bt = e * 4 + pn; u.ui = i; return true;
    }
};

__device__ __forceinline__ unsigned cvt_pk_bf16(float lo, float hi) { unsigned r; asm volatile("v_cvt_pk_bf16_f32 %0, %1, %2" : "=v"(r) : "v"(lo), "v"(hi)); return r; }
__device__ __forceinline__ u32x4 pack8(const f32x4 a, const f32x4 b) { u32x4 w; w.x = cvt_pk_bf16(a[0], a[1]); w.y = cvt_pk_bf16(a[2], a[3]); w.z = cvt_pk_bf16(b[0], b[1]); w.w = cvt_pk_bf16(b[2], b[3]); return w; }

__device__ __forceinline__ u32x4 dpp_ror8(u32x4 v) { u32x4 r; r.x = (unsigned)__builtin_amdgcn_mov_dpp((int)v.x, 0x128, 0xF, 0xF, true); r.y = (unsigned)__builtin_amdgcn_mov_dpp((int)v.y, 0x128, 0xF, 0xF, true);
    r.z = (unsigned)__builtin_amdgcn_mov_dpp((int)v.z, 0x128, 0xF, 0xF, true); r.w = (unsigned)__builtin_amdgcn_mov_dpp((int)v.w, 0x128, 0xF, 0xF, true); return r; }
struct EpiBf16 {
    static constexpr bool PERM = true, WIDE = true;
    bf16_t* O; int ldc;
    __device__ __forceinline__ void operator()(const f32x4 (&acc)[2][2][4][2], const Unit& u, int wr, int wc, int fr, int fq) const {
        const bool hi8 = (fr & 8) != 0;
        const int row0 = u.pm * BM + wr * 64 + (fr & 7), col0 = u.pn * BM + wc * 64 + (hi8 ? 32 : 0) + 8 * fq;
#pragma unroll
        for (int ai = 0; ai < 2; ++ai)
#pragma unroll
            for (int m = 0; m < 4; ++m) { bf16_t* rowp = O + (size_t)(row0 + ai * HALF + m * 16) * ldc + col0;
                const u32x4 p0 = pack8(acc[ai][0][m][0], acc[ai][0][m][1]), p1 = pack8(acc[ai][1][m][0], acc[ai][1][m][1]);
                const u32x4 snd = hi8 ? p0 : p1, rcv = dpp_ror8(snd);
                *(u32x4*)rowp = hi8 ? rcv : p0;
                *(u32x4*)(rowp + (size_t)8 * ldc) = hi8 ? p1 : rcv; }
    }
};
struct EpiF32Res {
    static constexpr bool PERM = false, WIDE = false;
    const float* base; float* out; int ldc;
    __device__ __forceinline__ void operator()(const f32x4 (&acc)[2][2][4][2], const Unit& u, int wr, int wc, int fr, int fq) const {
        const int row0 = u.pm * BM + wr * 64 + fr, col0 = u.pn * BM + wc * 32 + 4 * fq;
#pragma unroll
        for (int ai = 0; ai < 2; ++ai)
#pragma unroll
            for (int m = 0; m < 4; ++m) { const size_t off = (size_t)(row0 + ai * HALF + m * 16) * ldc + col0;
                f32x4 bs[2][2];
#pragma unroll
                for (int bj = 0; bj < 2; ++bj)
#pragma unroll
                    for (int n = 0; n < 2; ++n) bs[bj][n] = *(const f32x4*)(base + off + bj * HALF + n * 16);
#pragma unroll
                for (int bj = 0; bj < 2; ++bj)
#pragma unroll
                    for (int n = 0; n < 2; ++n) *(f32x4*)(out + off + bj * HALF + n * 16) = bs[bj][n] + acc[ai][bj][m][n];
                if (m & 1) asm volatile("" ::: "memory"); }
    }
};
template <bool BASE_F32> struct EpiBf16Res {
    static constexpr bool PERM = true, WIDE = false;
    const void* base; bf16_t* out; int ldc;
    __device__ __forceinline__ void operator()(const f32x4 (&acc)[2][2][4][2], const Unit& u, int wr, int wc, int fr, int fq) const {
        const int row0 = u.pm * BM + wr * 64 + fr, col0 = u.pn * BM + wc * 32 + 8 * fq;
#pragma unroll
        for (int ai = 0; ai < 2; ++ai)
#pragma unroll
            for (int m = 0; m < 4; ++m) { const size_t off = (size_t)(row0 + ai * HALF + m * 16) * ldc + col0;
                f32x4 b0[2], b1[2];
#pragma unroll
                for (int bj = 0; bj < 2; ++bj) {
                    if constexpr (BASE_F32) { const float* bp = (const float*)base + off + bj * HALF; b0[bj] = *(const f32x4*)bp; b1[bj] = *(const f32x4*)(bp + 4); }
                    else { const u32x4 w = *(const u32x4*)((const bf16_t*)base + off + bj * HALF);
                        b0[bj] = (f32x4){__uint_as_float(w.x << 16), __uint_as_float(w.x & 0xffff0000u), __uint_as_float(w.y << 16), __uint_as_float(w.y & 0xffff0000u)};
                        b1[bj] = (f32x4){__uint_as_float(w.z << 16), __uint_as_float(w.z & 0xffff0000u), __uint_as_float(w.w << 16), __uint_as_float(w.w & 0xffff0000u)}; } }
#pragma unroll
                for (int bj = 0; bj < 2; ++bj) *(u32x4*)(out + off + bj * HALF) = pack8(b0[bj] + acc[ai][bj][m][0], b1[bj] + acc[ai][bj][m][1]);
                if (m & 1) asm volatile("" ::: "memory"); }
    }
};
struct EpiConvIn {
    static constexpr bool PERM = true, WIDE = false;
    bf16_t* O;
    __device__ __forceinline__ void operator()(const f32x4 (&acc)[2][2][4][2], const Unit& u, int wr, int wc, int fr, int fq) const {
        const int row0 = u.pm * BM + wr * 64 + fr;
        if (u.pn < 4) {
            const int col0 = u.pn * BM + wc * 32 + 8 * fq;
#pragma unroll
            for (int ai = 0; ai < 2; ++ai)
#pragma unroll
                for (int m = 0; m < 4; ++m) { bf16_t* rowp = O + (size_t)(row0 + ai * HALF + m * 16) * 2048 + col0;
#pragma unroll
                    for (int bj = 0; bj < 2; ++bj) *(u32x4*)(rowp + bj * HALF) = pack8(acc[ai][bj][m][0], acc[ai][bj][m][1]); }
        } else {
            const int col0 = 1024 + (u.pn - 4) * HALF + wc * 32 + 8 * fq;
#pragma unroll
            for (int ai = 0; ai < 2; ++ai)
#pragma unroll
                for (int m = 0; m < 4; ++m) *(u32x4*)(O + (size_t)(row0 + ai * HALF + m * 16) * 2048 + col0) = pack8(acc[ai][0][m][0] * acc[ai][1][m][0], acc[ai][0][m][1] * acc[ai][1][m][1]);
        }
    }
};
__device__ __forceinline__ float silu_f(float x) { return x * __builtin_amdgcn_rcpf(1.0f + __builtin_amdgcn_exp2f(-1.4426950408889634f * x)); }
__device__ __forceinline__ float clamp448(float x) { return __builtin_fminf(__builtin_fmaxf(x, -448.f), 448.f); }
__device__ __forceinline__ unsigned pk4_fp8(float a, float b, float c, float d) { int w = 0; w = __builtin_amdgcn_cvt_pk_fp8_f32(clamp448(a), clamp448(b), w, false); w = __builtin_amdgcn_cvt_pk_fp8_f32(clamp448(c), clamp448(d), w, true); return (unsigned)w; }
template <bool F8> struct EpiSwiGLU {
    static constexpr bool PERM = true, WIDE = false;
    void* O; int ldc; float oscale;
    __device__ __forceinline__ void operator()(const f32x4 (&acc)[2][2][4][2], const Unit& u, int wr, int wc, int fr, int fq) const {
        const int row0 = u.pm * BM + wr * 64 + fr, col0 = u.pn * HALF + wc * 32 + 8 * fq;
#pragma unroll
        for (int ai = 0; ai < 2; ++ai)
#pragma unroll
            for (int m = 0; m < 4; ++m) {
                f32x4 h0, h1;
#pragma unroll
                for (int j = 0; j < 4; ++j) {
                    if constexpr (F8) {
                        h0[j] = acc[ai][0][m][0][j] * acc[ai][1][m][0][j] * __builtin_amdgcn_rcpf(1.0f + __builtin_amdgcn_exp2f(acc[ai][0][m][0][j]));
                        h1[j] = acc[ai][0][m][1][j] * acc[ai][1][m][1][j] * __builtin_amdgcn_rcpf(1.0f + __builtin_amdgcn_exp2f(acc[ai][0][m][1][j])); }
                    else { h0[j] = silu_f(acc[ai][0][m][0][j]) * acc[ai][1][m][0][j]; h1[j] = silu_f(acc[ai][0][m][1][j]) * acc[ai][1][m][1][j]; } }
                const size_t off = (size_t)(row0 + ai * HALF + m * 16) * ldc + col0;
                if constexpr (F8) { typedef unsigned u32x2 __attribute__((ext_vector_type(2)));
                    u32x2 w; w.x = pk4_fp8(h0[0], h0[1], h0[2], h0[3]); w.y = pk4_fp8(h1[0], h1[1], h1[2], h1[3]); __builtin_nontemporal_store(w, (u32x2*)((unsigned char*)O + off)); }
                else *(u32x4*)((bf16_t*)O + off) = pack8(h0, h1); }
    }
};
struct EpiScaleBf16 {
    static constexpr bool PERM = true, WIDE = false;
    bf16_t* O; int ldc; const float* rowscale;
    __device__ __forceinline__ void operator()(const f32x4 (&acc)[2][2][4][2], const Unit& u, int wr, int wc, int fr, int fq) const {
        const int row0 = u.pm * BM + wr * 64 + fr, col0 = u.pn * BM + wc * 32 + 8 * fq;
        float sc[2][4];
#pragma unroll
        for (int ai = 0; ai < 2; ++ai)
#pragma unroll
            for (int m = 0; m < 4; ++m) sc[ai][m] = rowscale[row0 + ai * HALF + m * 16];
#pragma unroll
        for (int ai = 0; ai < 2; ++ai)
#pragma unroll
            for (int m = 0; m < 4; ++m) { bf16_t* rowp = O + (size_t)(row0 + ai * HALF + m * 16) * ldc + col0; const float s = sc[ai][m];
#pragma unroll
                for (int bj = 0; bj < 2; ++bj) *(u32x4*)(rowp + bj * HALF) = pack8(acc[ai][bj][m][0] * s, acc[ai][bj][m][1] * s); }
    }
};
struct EpiScaleF8 {
    static constexpr bool PERM = true, WIDE = false;
    unsigned char* O; int ldc; const PG8_LAS float* rsc;
    __device__ __forceinline__ void operator()(const f32x4 (&acc)[2][2][4][2], const Unit& u, int wr, int wc, int fr, int fq) const {
        typedef unsigned u32x2 __attribute__((ext_vector_type(2)));
        const int row0 = u.pm * BM + wr * 64 + fr, col0 = u.pn * BM + wc * 32 + 8 * fq;
        float sc[2][4];
#pragma unroll
        for (int ai = 0; ai < 2; ++ai)
#pragma unroll
            for (int m = 0; m < 4; ++m) sc[ai][m] = rsc[u.ui * 256 + wr * 64 + fr + ai * HALF + m * 16];
#pragma unroll
        for (int ai = 0; ai < 2; ++ai)
#pragma unroll
            for (int m = 0; m < 4; ++m) { unsigned char* rowp = O + (size_t)(row0 + ai * HALF + m * 16) * ldc + col0; const float s_ = sc[ai][m];
#pragma unroll
                for (int bj = 0; bj < 2; ++bj) { const f32x4 a = acc[ai][bj][m][0] * s_, b = acc[ai][bj][m][1] * s_; u32x2 w; w.x = pk4_fp8(a[0], a[1], a[2], a[3]); w.y = pk4_fp8(b[0], b[1], b[2], b[3]); *(u32x2*)(rowp + bj * HALF) = w; } }
    }
};
struct EpiQKV {
    static constexpr bool PERM = true, WIDE = false;
    bf16_t *Q, *Kb, *Vb; const float *gq, *gk, *cosT, *sinT; float qscale;
    __device__ __forceinline__ void operator()(const f32x4 (&acc)[2][2][4][2], const Unit& u, int wr, int wc, int fr, int fq) const {
        const int row0 = u.pm * BM + wr * 64 + fr;
        if (u.pn < 5) {
            const bool isq = u.pn < 4;
            const float* g = isq ? gq : gk;
            bf16_t* base = isq ? Q + (u.pn * 4 + wc) * 64 : Kb + wc * 64; const int ldc = isq ? 1024 : 256;
            const float osc = isq ? qscale : 1.0f;
            f32x4 gn[2][2];
#pragma unroll
            for (int bj = 0; bj < 2; ++bj)
#pragma unroll
                for (int n = 0; n < 2; ++n) gn[bj][n] = *(const f32x4*)(g + 32 * bj + 16 * n + 4 * fq);
#pragma unroll
            for (int ai = 0; ai < 2; ++ai)
#pragma unroll
                for (int m = 0; m < 4; ++m) {
                    const int r = row0 + ai * HALF + m * 16, t = r & 4095, pr = t >> 6, pc = t & 63;
                    float ss = 0.f;
#pragma unroll
                    for (int bj = 0; bj < 2; ++bj)
#pragma unroll
                        for (int n = 0; n < 2; ++n) { const f32x4 x = acc[ai][bj][m][n]; ss += (x[0] * x[0] + x[1] * x[1]) + (x[2] * x[2] + x[3] * x[3]); }
                    ss += __shfl_xor(ss, 16); ss += __shfl_xor(ss, 32);
                    const float rs = osc / sqrtf(ss * (1.0f / 64.0f) + 1e-6f);
#pragma unroll
                    for (int bj = 0; bj < 2; ++bj) {
                        const int pos = bj ? pc : pr;
                        const f32x4 c4 = *(const f32x4*)(cosT + pos * 16 + 4 * fq), s4 = *(const f32x4*)(sinT + pos * 16 + 4 * fq);
                        const f32x4 x1 = acc[ai][bj][m][0] * rs * gn[bj][0], x2 = acc[ai][bj][m][1] * rs * gn[bj][1];
                        const f32x4 o1 = x1 * c4 - x2 * s4, o2 = x2 * c4 + x1 * s4;
                        *(u32x4*)(base + (size_t)r * ldc + 32 * bj + 8 * fq) = pack8(o1, o2);
                    }
                    asm volatile("" ::: "memory");
                }
        } else {
#pragma unroll
            for (int ai = 0; ai < 2; ++ai)
#pragma unroll
                for (int m = 0; m < 4; ++m) { const int r = row0 + ai * HALF + m * 16;
#pragma unroll
                    for (int bj = 0; bj < 2; ++bj) *(u32x4*)(Vb + (size_t)r * 256 + wc * 64 + 32 * bj + 8 * fq) = pack8(acc[ai][bj][m][0], acc[ai][bj][m][1]); }
        }
    }
};

struct EpiQKV8 {
    static constexpr bool PERM = true, WIDE = false;
    unsigned char *Q8, *K8, *V8p; const PG8_LAS float* tab; float qscale, kscale, vscale;
    __device__ __forceinline__ void operator()(const f32x4 (&acc)[2][2][4][2], const Unit& u, int wr, int wc, int fr, int fq) const {
        typedef unsigned u32x2 __attribute__((ext_vector_type(2)));
        const int row0 = u.pm * BM + wr * 64 + fr;
        if (u.pn < 5) {
            const bool isq = u.pn < 4;
            const PG8_LAS float* g = tab + 2048 + (isq ? 0 : 64);
            unsigned char* base = isq ? Q8 + (u.pn * 4 + wc) * 64 : K8 + wc * 64; const int ldc = isq ? 1024 : 256;
            const float osc = isq ? qscale : kscale;
            f32x4 gn[2][2];
#pragma unroll
            for (int bj = 0; bj < 2; ++bj)
#pragma unroll
                for (int n = 0; n < 2; ++n) gn[bj][n] = *(const PG8_LAS f32x4*)(g + 32 * bj + 16 * n + 4 * fq);
#pragma unroll
            for (int ai = 0; ai < 2; ++ai)
#pragma unroll
                for (int m = 0; m < 4; ++m) {
                    const int r = row0 + ai * HALF + m * 16, t = r & 4095, pr = t >> 6, pc = t & 63;
                    float ss = 0.f;
#pragma unroll
                    for (int bj = 0; bj < 2; ++bj)
#pragma unroll
                        for (int n = 0; n < 2; ++n) { const f32x4 x = acc[ai][bj][m][n]; ss += (x[0] * x[0] + x[1] * x[1]) + (x[2] * x[2] + x[3] * x[3]); }
                    ss += __shfl_xor(ss, 16); ss += __shfl_xor(ss, 32);
                    const float rs = osc / sqrtf(ss * (1.0f / 64.0f) + 1e-6f);
#pragma unroll
                    for (int bj = 0; bj < 2; ++bj) {
                        const int pos = bj ? pc : pr;
                        const f32x4 c4 = *(const PG8_LAS f32x4*)(tab + pos * 16 + 4 * fq), s4 = *(const PG8_LAS f32x4*)(tab + 1024 + pos * 16 + 4 * fq);
                        const f32x4 x1 = acc[ai][bj][m][0] * rs * gn[bj][0], x2 = acc[ai][bj][m][1] * rs * gn[bj][1];
                        const f32x4 o1 = x1 * c4 - x2 * s4, o2 = x2 * c4 + x1 * s4;
                        u32x2 w; w.x = pk4_fp8(o1[0], o1[1], o1[2], o1[3]); w.y = pk4_fp8(o2[0], o2[1], o2[2], o2[3]);
                        *(u32x2*)(base + (size_t)r * ldc + 32 * bj + 8 * fq) = w;
                    }
                    if (m & 1) asm volatile("" ::: "memory");
                }
        } else {
            const bool even = (fr & 1) == 0;
#pragma unroll
            for (int ai = 0; ai < 2; ++ai)
#pragma unroll
                for (int m = 0; m < 4; ++m) { const int r = row0 + ai * HALF + m * 16;
#pragma unroll
                    for (int bj = 0; bj < 2; ++bj) { const f32x4 a = acc[ai][bj][m][0] * vscale, b = acc[ai][bj][m][1] * vscale;
                        const unsigned ox = pk4_fp8(a[0], a[1], a[2], a[3]), oy = pk4_fp8(b[0], b[1], b[2], b[3]);
                        const unsigned rx = (unsigned)__builtin_amdgcn_mov_dpp((int)ox, 0xB1, 0xF, 0xF, true), ry = (unsigned)__builtin_amdgcn_mov_dpp((int)oy, 0xB1, 0xF, 0xF, true);
                        const unsigned A = even ? ox : ry, B = even ? rx : oy;
                        u32x2 w; w.x = __builtin_amdgcn_perm(B, A, 0x05010400u); w.y = __builtin_amdgcn_perm(B, A, 0x07030602u);
                        *(u32x2*)(V8p + ((size_t)(r >> 1) * 256 + wc * 64 + 32 * bj + 8 * fq + 4 * (fr & 1)) * 2) = w; } }
        }
    }
};

template <class Epi, class Sched, bool GATHER, bool FP8 = false, int KREP = 1>
__device__ __forceinline__ void gemm_phase(PG8_LAS unsigned char* lds, const Gemm g, const Sched& S, const Epi& E) {
    const int tid = threadIdx.x, wid = __builtin_amdgcn_readfirstlane(tid >> 6), lane = tid & 63, wr = wid >> 2, wc = wid & 3, fr = lane & 15, fq = lane >> 4;
    const int KB = FP8 ? g.K : g.K * 2, nt = KB / 128;
    unsigned voffA[2], voffB[2]; int RA[2], CA[2];
#pragma unroll
    for (int i = 0; i < 2; ++i) { int R, C;
        if constexpr (FP8) { const int P = tid + 512 * i, hb = P & 1, q = P >> 1, fr_ = q & 15, fq_ = (q >> 4) & 3, mp = q >> 6; R = 16 * mp + fr_; C = 32 * fq_ + 16 * (hb ^ ((fr_ >> 3) & 1)); }
        else { stage_rc(tid * 16 + i * 8192, R, C); C *= 2; }
        const int Rb = Epi::WIDE ? (64 * (R >> 5) + perm32(R & 31)) : (Epi::PERM ? ((R & ~31) + perm32(R & 31)) : R);
        voffA[i] = (unsigned)(R * KB + C); voffB[i] = (unsigned)(Rb * KB + C); RA[i] = R; CA[i] = C; }
    const size_t kstep = (size_t)128;
    const size_t hstep = (size_t)HALF * KB, hstepB = Epi::WIDE ? (size_t)32 * KB : hstep;
    const size_t tstep = 2 * hstep;
    const unsigned ldsw = (unsigned)wid * 1024u;
    const int aoff = FP8 ? (wr * 8192 + lane * 32 + 16 * ((lane >> 3) & 1)) : lds_byte(wr * 64 + fr, fq * 8), boff = FP8 ? (wc * 4096 + lane * 32 + 16 * ((lane >> 3) & 1)) : lds_byte(wc * 32 + fr, fq * 8);
    const int aoff1 = aoff ^ 16, boff1 = boff ^ 16;
    const int sa = g.sa, sb = g.sb, sb1 = g.sb1;
#define PG8_SA(b, h) (((b) * 2 + (h)) * HTB)
#define PG8_SB(b, h) ((4 + (b) * 2 + (h)) * HTB)
#define PG8_STAGE(bufoff, gbase, voff) do { _Pragma("unroll") for (int _i = 0; _i < 2; ++_i) \
        __builtin_amdgcn_global_load_lds((const unsigned*)((const char*)(gbase) + (voff)[_i]), (PG8_LAS unsigned*)(lds + (bufoff) + ldsw + _i * 8192), 16, 0, 0); } while (0)
#define PG8_STAGE_A(bufoff, p, h, usenext) do { if constexpr (GATHER) { unsigned _o[2]; _o[0] = (usenext) ? on[h][0] : oc[h][0]; _o[1] = (usenext) ? on[h][1] : oc[h][1]; PG8_STAGE(bufoff, p, _o); } \
        else { PG8_STAGE(bufoff, (p) + (h) * hstep, voffA); } } while (0)
#define PG8_LD8(p0, p1) __builtin_shufflevector(*(const PG8_LAS i32x4*)(p0), *(const PG8_LAS i32x4*)(p1), 0, 1, 2, 3, 4, 5, 6, 7)
#define PG8_LDA(dst, b, h) do { _Pragma("unroll") for (int m = 0; m < 4; ++m) { if constexpr (FP8) { dst##8[m] = PG8_LD8(lds + PG8_SA(b, h) + aoff + m * 2048, lds + PG8_SA(b, h) + aoff1 + m * 2048); } \
        else { _Pragma("unroll") for (int k = 0; k < 2; ++k) dst[m][k] = *(const PG8_LAS bf16x8*)(lds + PG8_SA(b, h) + aoff + m * 2048 + k * 1024); } } } while (0)
#define PG8_LDB(dst, b, h) do { _Pragma("unroll") for (int n = 0; n < 2; ++n) { if constexpr (FP8) { dst##8[n] = PG8_LD8(lds + PG8_SB(b, h) + boff + n * 2048, lds + PG8_SB(b, h) + boff1 + n * 2048); } \
        else { _Pragma("unroll") for (int k = 0; k < 2; ++k) dst[n][k] = *(const PG8_LAS bf16x8*)(lds + PG8_SB(b, h) + boff + n * 2048 + k * 1024); } } } while (0)
#define PG8_MMA(ai, bj, At, Bt, Z) do { __builtin_amdgcn_s_setprio(1); \
        if (FP8 && (Z)) { _Pragma("unroll") for (int m = 0; m < 4; ++m) _Pragma("unroll") for (int n = 0; n < 2; ++n) {              \
            if constexpr (FP8) asm volatile("v_mfma_scale_f32_16x16x128_f8f6f4 %0, %1, %2, 0, %3, %4 op_sel_hi:[0,0,0]" : "=v"(acc[ai][bj][m][n]) : "v"(Bt##8[n]), "v"(At##8[m]), "v"((bj) ? sb1 : sb), "v"(sa)); \
            else { acc[ai][bj][m][n] = __builtin_amdgcn_mfma_f32_16x16x32_bf16(Bt[n][0], At[m][0], (f32x4){0.f, 0.f, 0.f, 0.f}, 0, 0, 0); acc[ai][bj][m][n] = __builtin_amdgcn_mfma_f32_16x16x32_bf16(Bt[n][1], At[m][1], acc[ai][bj][m][n], 0, 0, 0); } } } \
        else { _Pragma("unroll") for (int m = 0; m < 4; ++m) _Pragma("unroll") for (int n = 0; n < 2; ++n) { \
            if constexpr (FP8) asm volatile("v_mfma_scale_f32_16x16x128_f8f6f4 %0, %1, %2, %0, %3, %4 op_sel_hi:[0,0,0]" : "+v"(acc[ai][bj][m][n]) : "v"(Bt##8[n]), "v"(At##8[m]), "v"((bj) ? sb1 : sb), "v"(sa)); \
            else { _Pragma("unroll") for (int k = 0; k < 2; ++k) acc[ai][bj][m][n] = __builtin_amdgcn_mfma_f32_16x16x32_bf16(Bt[n][k], At[m][k], acc[ai][bj][m][n], 0, 0, 0); } } } \
        __builtin_amdgcn_s_setprio(0); } while (0)
#define PG8_WAIT_V(n) asm volatile("s_waitcnt vmcnt(" #n ")" ::: "memory")
#define PG8_WAIT_L(n) asm volatile("s_waitcnt lgkmcnt(" #n ")" ::: "memory")
#define PG8_BAR __builtin_amdgcn_s_barrier()
#define PG8_SCHED __builtin_amdgcn_sched_barrier(0)
#define PG8_GOFF(dst, ui_) do { _Pragma("unroll") for (int _h = 0; _h < 2; ++_h) _Pragma("unroll") for (int _i = 0; _i < 2; ++_i) dst[_h][_i] = g.gidx[(ui_) * 256 + _h * HALF + RA[_i]] + (unsigned)CA[_i]; } while (0)
    Unit cur, nxt; int ui = 0;
    if (!S.next(0, cur)) return;
    f32x4 acc[2][2][4][2];
#define PG8_ZERO_ACC do { if constexpr (!FP8) { _Pragma("unroll") for (int a = 0; a < 2; ++a) _Pragma("unroll") for (int b = 0; b < 2; ++b) _Pragma("unroll") for (int m = 0; m < 4; ++m) _Pragma("unroll") for (int n = 0; n < 2; ++n) \
        acc[a][b][m][n] = (f32x4){0.f, 0.f, 0.f, 0.f}; } } while (0)
    PG8_ZERO_ACC;
    bf16x8 At[4][2], B0[2][2], B1[2][2]; i32x8 At8[4], B08[2], B18[2];
    unsigned oc[2][2], on[2][2];
    if constexpr (GATHER) { PG8_GOFF(oc, 0); PG8_WAIT_L(0); }
#pragma unroll
    for (int h = 0; h < 2; ++h)
#pragma unroll
        for (int i = 0; i < 2; ++i) { if constexpr (!GATHER) oc[h][i] = 0u; on[h][i] = oc[h][i]; }
    const char* cA = GATHER ? (const char*)g.A : (const char*)g.A + (size_t)cur.pm * tstep; const char* cB = (const char*)g.Bt + (size_t)cur.bt * tstep;
    PG8_STAGE(PG8_SB(0, 0), cB, voffB); PG8_STAGE(PG8_SB(0, 1), cB + hstepB, voffB); PG8_STAGE_A(PG8_SA(0, 0), cA, 0, false); PG8_STAGE_A(PG8_SA(0, 1), cA, 1, false);
    if (wr == 1) PG8_BAR;
    PG8_WAIT_V(2); PG8_BAR;
    PG8_STAGE(PG8_SB(1, 0), cB + kstep, voffB); PG8_STAGE_A(PG8_SA(1, 0), cA + kstep, 0, false); PG8_STAGE(PG8_SB(1, 1), cB + hstepB + kstep, voffB);
    PG8_WAIT_V(6); PG8_BAR;
    for (;;) {
        const bool has_next = S.next(ui + 1, nxt);
        const char* nA = GATHER ? cA : (has_next ? (const char*)g.A + (size_t)nxt.pm * tstep : cA); const char* nB = has_next ? (const char*)g.Bt + (size_t)nxt.bt * tstep : cB;
        if constexpr (GATHER) { if (has_next) { PG8_GOFF(on, ui + 1); } }
        for (int tt = 0; tt < nt * KREP; tt += 2) {
            const int t = KREP == 1 ? tt : tt % nt;
            const bool zf = FP8 && (tt == 0); const bool lastr = (t == nt - 2), last = lastr && (tt == nt * KREP - 2);
            const char* a1 = cA + (size_t)(t + 1) * kstep;
            const char* a2 = last ? nA : (lastr ? cA : cA + (size_t)(t + 2) * kstep); const char* b2 = last ? nB : (lastr ? cB : cB + (size_t)(t + 2) * kstep);
            const char* a3 = a2 + kstep; const char* b3 = b2 + kstep;
            PG8_LDB(B0, 0, 0); PG8_LDB(B1, 0, 1); PG8_SCHED; PG8_LDA(At, 0, 0); PG8_STAGE_A(PG8_SA(1, 1), a1, 1, false);
            PG8_WAIT_V(8); PG8_WAIT_L(0); PG8_BAR; PG8_MMA(0, 0, At, B0, zf); PG8_MMA(0, 1, At, B1, zf); PG8_BAR; PG8_SCHED;
            PG8_LDA(At, 0, 1); PG8_STAGE(PG8_SB(0, 0), b2, voffB); PG8_STAGE(PG8_SB(0, 1), b2 + hstepB, voffB); PG8_STAGE_A(PG8_SA(0, 0), a2, 0, last);
            PG8_WAIT_V(8); PG8_WAIT_L(0); PG8_BAR; PG8_MMA(1, 0, At, B0, zf); PG8_MMA(1, 1, At, B1, zf); PG8_BAR; PG8_SCHED;
            PG8_LDB(B0, 1, 0); PG8_LDB(B1, 1, 1); PG8_SCHED; PG8_LDA(At, 1, 0); PG8_STAGE_A(PG8_SA(0, 1), a2, 1, last);
            PG8_WAIT_V(8); PG8_WAIT_L(0); PG8_BAR; PG8_MMA(0, 0, At, B0, false); PG8_MMA(0, 1, At, B1, false); PG8_BAR; PG8_SCHED;
            PG8_LDA(At, 1, 1); PG8_STAGE(PG8_SB(1, 0), b3, voffB); PG8_STAGE(PG8_SB(1, 1), b3 + hstepB, voffB); PG8_STAGE_A(PG8_SA(1, 0), a3, 0, last);
            PG8_WAIT_V(8); PG8_WAIT_L(0); PG8_BAR; PG8_MMA(1, 0, At, B0, false); PG8_MMA(1, 1, At, B1, false); PG8_BAR; PG8_SCHED;
        }
        if (wr == 0) PG8_BAR;
        if constexpr (FP8) asm volatile("s_nop 15\n\ts_nop 15" ::: "memory");
        if constexpr (KREP > 1) {
#pragma unroll
            for (int a = 0; a < 2; ++a)
#pragma unroll
                for (int b = 0; b < 2; ++b)
#pragma unroll
                    for (int m = 0; m < 4; ++m)
#pragma unroll
                        for (int n = 0; n < 2; ++n) acc[a][b][m][n] = acc[a][b][m][n] * (1.0f / KREP); }
        E(acc, cur, wr, wc, fr, fq);
        if (!has_next) break;
        PG8_ZERO_ACC;
        cur = nxt; cA = nA; cB = nB; ++ui;
#pragma unroll
        for (int h = 0; h < 2; ++h)
#pragma unroll
            for (int i = 0; i < 2; ++i) oc[h][i] = on[h][i];
        if (wr == 1) PG8_BAR;
    }
    PG8_WAIT_V(0);
    PG8_BAR;
#undef PG8_SA
#undef PG8_SB
#undef PG8_STAGE
#undef PG8_STAGE_A
#undef PG8_LDA
#undef PG8_LDB
#undef PG8_MMA
#undef PG8_LD8
#undef PG8_WAIT_V
#undef PG8_WAIT_L
#undef PG8_BAR
#undef PG8_SCHED
#undef PG8_GOFF
#undef PG8_ZERO_ACC
}
}

namespace attn_body {
using bf16=__hip_bfloat16;
using bf16x8=__attribute__((ext_vector_type(8)))short;
using s16x4=__attribute__((ext_vector_type(4)))short;
using f32x16=__attribute__((ext_vector_type(16)))float;
using u32x4=__attribute__((ext_vector_type(4)))unsigned;
constexpr int BATCH=8,NHEAD=16,NKV=4,SEQ=4096,D=64,QP=NHEAD*D,KP=NKV*D;
constexpr int NW=8,QBLK=32,QB=QBLK*NW,KVBLK=64,NQB=SEQ/QB;
__device__ __forceinline__ int crow(int r,int hi){return (r&3)+8*(r>>2)+4*hi;}
#define SBAR() __builtin_amdgcn_sched_barrier(0)
constexpr int NSLOT=3, SLOTB=8192;
constexpr int LDS_K=0, LDS_V=NSLOT*SLOTB, LDS_WS=2*NSLOT*SLOTB, LDS_OST=LDS_WS+NW*64*4, LDS_BYTES=LDS_OST+NW*4096;
constexpr float C2=0.125f*1.4426950408889634f;
__device__ __forceinline__ void glds16(const void*gsrc,unsigned lds_dst){unsigned keep;
  asm volatile("s_mov_b32 %0, m0\n\ts_mov_b32 m0, %2\n\ts_nop 0\n\tglobal_load_lds_dwordx4 %1, off\n\ts_mov_b32 m0, %0":"=&s"(keep):"v"(gsrc),"s"(lds_dst):"memory");}
__device__ __forceinline__ float max3f(float a,float b,float c){float r;asm("v_max3_f32 %0, %1, %2, %3":"=v"(r):"v"(a),"v"(b),"v"(c));return r;}
__device__ __forceinline__ float max2f(float a,float b){float r;asm("v_max_f32_e32 %0, %1, %2":"=v"(r):"v"(a),"v"(b));return r;}
__device__ __forceinline__ float fadd_s(float a,float b){float r;asm("v_add_f32_e32 %0, %1, %2":"=v"(r):"v"(a),"v"(b));return r;}
__device__ __forceinline__ float fsub_s(float a,float b){float r;asm("v_sub_f32_e32 %0, %1, %2":"=v"(r):"v"(a),"v"(b));return r;}
typedef float f32x2_t __attribute__((ext_vector_type(2))); typedef __bf16 bf16x2_t __attribute__((ext_vector_type(2)));
__device__ __forceinline__ unsigned cvtpk_s(float lo,float hi){f32x2_t v={lo,hi};bf16x2_t b=__builtin_convertvector(v,bf16x2_t);return __builtin_bit_cast(unsigned,b);}
#define WAIT_BAR(N) asm volatile("s_waitcnt vmcnt(" #N ") lgkmcnt(0)\n\ts_barrier":::"memory")

__device__ __forceinline__ void qkt(f32x16&p0,f32x16&p1,const char*Kslot,const bf16x8*qr,const f32x16&negm,int r32,int hi){
  const char*kb=Kslot+hi*1024+r32*16;
  #pragma unroll
  for(int d0=0;d0<4;++d0){
    const bf16x8 b0=*reinterpret_cast<const bf16x8*>(kb+d0*2048);
    const bf16x8 b1=*reinterpret_cast<const bf16x8*>(kb+d0*2048+512);
    if(d0==0){p0=__builtin_amdgcn_mfma_f32_32x32x16_bf16(b0,qr[0],negm,0,0,0);p1=__builtin_amdgcn_mfma_f32_32x32x16_bf16(b1,qr[0],negm,0,0,0);}
    else{p0=__builtin_amdgcn_mfma_f32_32x32x16_bf16(b0,qr[d0],p0,0,0,0);p1=__builtin_amdgcn_mfma_f32_32x32x16_bf16(b1,qr[d0],p1,0,0,0);}}
}
typedef __attribute__((address_space(3))) const char* lds_cptr;
typedef short v4i16_t __attribute__((ext_vector_type(4)));
__device__ __forceinline__ void kload8(bf16x8*kf,lds_cptr kp){
  kf[0]=*(const __attribute__((address_space(3))) bf16x8*)(kp);      kf[1]=*(const __attribute__((address_space(3))) bf16x8*)(kp+512);
  kf[2]=*(const __attribute__((address_space(3))) bf16x8*)(kp+2048); kf[3]=*(const __attribute__((address_space(3))) bf16x8*)(kp+2560);
  kf[4]=*(const __attribute__((address_space(3))) bf16x8*)(kp+4096); kf[5]=*(const __attribute__((address_space(3))) bf16x8*)(kp+4608);
  kf[6]=*(const __attribute__((address_space(3))) bf16x8*)(kp+6144); kf[7]=*(const __attribute__((address_space(3))) bf16x8*)(kp+6656);
}
__device__ __forceinline__ void kload2(bf16x8*kf,lds_cptr kp,int j){ kf[2*j]=*(const __attribute__((address_space(3))) bf16x8*)(kp+j*2048); kf[2*j+1]=*(const __attribute__((address_space(3))) bf16x8*)(kp+j*2048+512); }
__device__ __forceinline__ s16x4 vtr(lds_cptr p){ return __builtin_bit_cast(s16x4,__builtin_amdgcn_ds_read_tr16_b64_v4i16((__attribute__((address_space(3))) v4i16_t*)p)); }
__device__ __forceinline__ float rowmax(const f32x16&p0,const f32x16&p1){
  float a=max3f(p0[0],p0[1],p1[0]),b=max3f(p0[2],p0[3],p1[1]);a=max3f(a,p1[2],p1[3]);
  #pragma unroll
  for(int r=4;r<16;r+=4){a=max3f(a,p0[r],p0[r+1]);b=max3f(b,p0[r+2],p0[r+3]);a=max3f(a,p1[r],p1[r+1]);b=max3f(b,p1[r+2],p1[r+3]);}
  const float m=max2f(a,b);
  auto rr=__builtin_amdgcn_permlane32_swap(__float_as_uint(m),__float_as_uint(m),false,false);
  return max2f(__uint_as_float(rr[0]),__uint_as_float(rr[1]));
}
__device__ __forceinline__ void pv(f32x16*o,int vb,bf16x8 pa0,bf16x8 pa1,bf16x8 pa2,bf16x8 pa3){
  #pragma unroll
  for(int d0=0;d0<2;++d0){s16x4 lo[4],hi[4];
    #pragma unroll
    for(int ks=0;ks<4;++ks){
      asm volatile("ds_read_b64_tr_b16 %0,%1 offset:%c2":"=&v"(lo[ks]):"v"(vb),"i"(d0*4096+ks*1024):"memory");
      asm volatile("ds_read_b64_tr_b16 %0,%1 offset:%c2":"=&v"(hi[ks]):"v"(vb),"i"(d0*4096+ks*1024+512):"memory");}
    asm volatile("s_waitcnt lgkmcnt(0)":::"memory");SBAR();
    #define PK(k) (bf16x8){lo[k][0],lo[k][1],lo[k][2],lo[k][3],hi[k][0],hi[k][1],hi[k][2],hi[k][3]}
    o[d0]=__builtin_amdgcn_mfma_f32_32x32x16_bf16(pa0,PK(0),o[d0],0,0,0);
    o[d0]=__builtin_amdgcn_mfma_f32_32x32x16_bf16(pa1,PK(1),o[d0],0,0,0);
    o[d0]=__builtin_amdgcn_mfma_f32_32x32x16_bf16(pa2,PK(2),o[d0],0,0,0);
    o[d0]=__builtin_amdgcn_mfma_f32_32x32x16_bf16(pa3,PK(3),o[d0],0,0,0);
    #undef PK
  }
}
#define ATTN_STORE16(p,v) (*(u32x4*)(p)=(v))
template<int THRL> __device__ __forceinline__ void attn_unit(int b,int h,int qb,const bf16*Q,const bf16*__restrict__ K,const bf16*__restrict__ V,bf16*O,char*shm){
  const int tid=threadIdx.x,lane=tid&63,r32=lane&31,hi=lane>>5; const int wid=__builtin_amdgcn_readfirstlane(tid>>6);
  const long rowbase=(long)b*SEQ; const int q0=qb*QB; const int kvh=h/(NHEAD/NKV);
  const bf16*Qw=Q+(rowbase+q0+wid*QBLK)*QP+h*D;
  const bf16*Kh=K+rowbase*KP+kvh*D,*Vh=V+rowbase*KP+kvh*D;
  const unsigned lds0=(unsigned)(uintptr_t)shm;
  float*wsf=(float*)(shm+LDS_WS)+wid*64;
  const bf16*ksrc=Kh+(long)lane*KP+wid*8;
  const bf16*vsrc=Vh+(long)(16*(wid&3)+(lane>>2))*KP+(wid>>2)*32+(lane&3)*8;
  const unsigned kdst=lds0+LDS_K+wid*1024, vdst=lds0+LDS_V+wid*1024;
  #define DMA_K(t,slot) glds16(ksrc+(long)(t)*KVBLK*KP,(unsigned)__builtin_amdgcn_readfirstlane(kdst+(slot)))
  #define DMA_V(t,slot) glds16(vsrc+(long)(t)*KVBLK*KP,(unsigned)__builtin_amdgcn_readfirstlane(vdst+(slot)))
  const int vb0=(int)(lds0+LDS_V)+((lane>>4)&1)*32+(lane&3)*8+(4*hi+((lane&15)>>2))*64;
  const char*Kbase=shm+LDS_K; bf16x8 kf[8];
  const lds_cptr shm3=(lds_cptr)shm; const lds_cptr kp0=shm3+LDS_K+hi*1024+r32*16; const lds_cptr vp0=shm3+LDS_V+((lane>>4)&1)*32+(lane&3)*8+(4*hi+((lane&15)>>2))*64;
  constexpr int NT=SEQ/KVBLK;
  DMA_K(0,0);DMA_V(0,0);DMA_K(1,SLOTB);
  bf16x8 qr[4];
  #pragma unroll
  for(int d0=0;d0<4;++d0)qr[d0]=*reinterpret_cast<const bf16x8*>(&Qw[(long)r32*QP+d0*16+hi*8]);
  float mhat=0.f,l_reg=0.f;f32x16 o[2];o[0]=f32x16{};o[1]=f32x16{};f32x16 negm=f32x16{};asm volatile("":"+v"(negm));
  bool resc=false;
  #define START(P0,P1) do{ const float rm=rowmax(P0,P1); resc=false; \
    { const float dl=rm; mhat=fadd_s(mhat,dl); \
      _Pragma("unroll") for(int r=0;r<16;++r){P0[r]=fsub_s(P0[r],dl);P1[r]=fsub_s(P1[r],dl);} \
      _Pragma("unroll") for(int r=0;r<16;++r)negm[r]=-mhat; asm volatile("":"+v"(negm)); } \
    _Pragma("unroll") for(int r=0;r<16;++r)P0[r]=__builtin_amdgcn_exp2f(P0[r]); }while(0)
  #define RESC() do{ if(resc){ asm volatile("s_waitcnt lgkmcnt(0)":::"memory"); \
      _Pragma("unroll") for(int d_=0;d_<2;++d_) _Pragma("unroll") for(int r=0;r<16;++r)o[d_][r]*=wsf[crow(r,hi)]; } }while(0)
  f32x16 pA0,pA1,pB0,pB1;
  int sl_prev=0,sl_cur=0,sl_next=SLOTB;
  #define ROT() do{sl_prev=sl_cur;sl_cur=sl_next;sl_next=(sl_next==(NSLOT-1)*SLOTB)?0:sl_next+SLOTB;}while(0)
  DMA_K(2,2*SLOTB);
  WAIT_BAR(3);
  qkt(pA0,pA1,Kbase,qr,negm,r32,hi);asm volatile("s_nop 15\n\ts_nop 7":"+v"(pA0),"+v"(pA1));
  START(pA0,pA1);
  _Pragma("unroll") for(int r=0;r<16;++r)pA1[r]=__builtin_amdgcn_exp2f(pA1[r]);
  WAIT_BAR(0);
  DMA_K(3,0);DMA_V(1,SLOTB);
  ROT();
  kload8(kf,kp0+sl_cur);
  WAIT_BAR(2);
  s16x4 vlo[8],vhi[8]; u32x4 pw0,pw1,pw2,pw3;
  #define PKW(P,B) cvtpk_s(P[B],P[B+1])
  #define PAF(k) __builtin_bit_cast(bf16x8,pw##k)
  #define VFR(i) (bf16x8){vlo[i][0],vlo[i][1],vlo[i][2],vlo[i][3],vhi[i][0],vhi[i][1],vhi[i][2],vhi[i][3]}
  #define PIN(x) asm volatile("":"+v"(x))
  #define MX3(a,b,c) __builtin_fmaxf(__builtin_fmaxf((a),(b)),(c))
  #define GAPA(MF,A0,A1,A2,A3,W0,W1,PW) do{ MF; sacc+=A0; sacc+=A1; sacc+=A2; sacc+=A3; PIN(sacc); W0; W1; PIN(PW); SBAR(); }while(0)
  #define EX(v) __builtin_amdgcn_exp2f(v)
  #define GAPB(MF,X,B) do{ MF; X[B]=EX(X[B]); X[B+1]=EX(X[B+1]); X[B+2]=EX(X[B+2]); X[B+3]=EX(X[B+3]); PIN(X); SBAR(); }while(0)
  #define VRD(i) do{ vlo[i]=vtr(vp_+(((i)>>2)*4096+((i)&3)*1024)); vhi[i]=vtr(vp_+(((i)>>2)*4096+((i)&3)*1024+512)); }while(0)
  #define KRD(G,j) do{ if(G){ kload2(kf,kp0+sl_next,j); SBAR(); } }while(0)
  #define STEP(C0,C1,P0,P1,t,GK,GV,GL) do{ SBAR(); \
    const lds_cptr vp_=vp0+sl_prev; \
    VRD(0); SBAR(); float sacc=(P0[0]+P0[1]); \
    GAPA(C0=__builtin_amdgcn_mfma_f32_32x32x16_bf16(kf[0],qr[0],negm,0,0,0), P0[2],P0[3],P0[4],P0[5],     pw0[0]=PKW(P0,0), pw0[1]=PKW(P0,2), pw0); \
    VRD(4); SBAR(); GAPA(C1=__builtin_amdgcn_mfma_f32_32x32x16_bf16(kf[1],qr[0],negm,0,0,0), P0[6],P0[7],P0[8],P0[9],     pw0[2]=PKW(P0,4), pw0[3]=PKW(P0,6), pw0); \
    VRD(1); SBAR(); GAPA(C0=__builtin_amdgcn_mfma_f32_32x32x16_bf16(kf[2],qr[1],C0,0,0,0),   P0[10],P0[11],P0[12],P0[13], pw1[0]=PKW(P0,8), pw1[1]=PKW(P0,10), pw1); \
    VRD(5); SBAR(); GAPA(C1=__builtin_amdgcn_mfma_f32_32x32x16_bf16(kf[3],qr[1],C1,0,0,0),   P0[14],P0[15],P1[0],P1[1],   pw1[2]=PKW(P0,12),pw1[3]=PKW(P0,14), pw1); \
    VRD(2); SBAR(); GAPA(C0=__builtin_amdgcn_mfma_f32_32x32x16_bf16(kf[4],qr[2],C0,0,0,0),   P1[2],P1[3],P1[4],P1[5],     pw2[0]=PKW(P1,0), pw2[1]=PKW(P1,2), pw2); \
    VRD(6); SBAR(); GAPA(C1=__builtin_amdgcn_mfma_f32_32x32x16_bf16(kf[5],qr[2],C1,0,0,0),   P1[6],P1[7],P1[8],P1[9],     pw2[2]=PKW(P1,4), pw2[3]=PKW(P1,6), pw2); \
    VRD(3); SBAR(); GAPA(C0=__builtin_amdgcn_mfma_f32_32x32x16_bf16(kf[6],qr[3],C0,0,0,0),   P1[10],P1[11],P1[12],P1[13], pw3[0]=PKW(P1,8), pw3[1]=PKW(P1,10), pw3); \
    VRD(7); SBAR(); GAPA(C1=__builtin_amdgcn_mfma_f32_32x32x16_bf16(kf[7],qr[3],C1,0,0,0),   P1[14],P1[15],0.f,0.f,       pw3[2]=PKW(P1,12),pw3[3]=PKW(P1,14), pw3); \
    l_reg+=sacc; \
    if(GK){DMA_K((t)+3,sl_cur);} if(GV){DMA_V((t)+1,sl_next);} \
    { float a=MX3(C0[0],C0[1],C1[0]),b=MX3(C0[2],C0[3],C1[1]); a=MX3(a,C1[2],C1[3]); \
      _Pragma("unroll") for(int r=4;r<16;r+=4){a=MX3(a,C0[r],C0[r+1]);b=MX3(b,C0[r+2],C0[r+3]);a=MX3(a,C1[r],C1[r+1]);b=MX3(b,C1[r+2],C1[r+3]);} \
      float rm=__builtin_fmaxf(a,b); { auto rr=__builtin_amdgcn_permlane32_swap(__float_as_uint(rm),__float_as_uint(rm),false,false); rm=__builtin_fmaxf(__uint_as_float(rr[0]),__uint_as_float(rr[1])); } \
      resc=false; \
      if(__builtin_expect(__any(rm>(float)THRL),0)){ const float dl=__builtin_fmaxf(rm,0.f); mhat+=dl; \
        _Pragma("unroll") for(int r=0;r<16;++r){C0[r]-=dl;C1[r]-=dl;} \
        _Pragma("unroll") for(int r=0;r<16;++r)negm[r]=-mhat; asm volatile("":"+v"(negm)); \
        const float f=__builtin_amdgcn_exp2f(-dl); l_reg*=f; if(hi==0)wsf[r32]=f; resc=true; } } \
    SBAR(); \
    GAPB(o[0]=__builtin_amdgcn_mfma_f32_32x32x16_bf16(PAF(0),VFR(0),o[0],0,0,0), C0,0); \
    GAPB(o[1]=__builtin_amdgcn_mfma_f32_32x32x16_bf16(PAF(0),VFR(4),o[1],0,0,0), C0,4); \
    KRD(GL,0); GAPB(o[0]=__builtin_amdgcn_mfma_f32_32x32x16_bf16(PAF(1),VFR(1),o[0],0,0,0), C0,8); \
    KRD(GL,1); GAPB(o[1]=__builtin_amdgcn_mfma_f32_32x32x16_bf16(PAF(1),VFR(5),o[1],0,0,0), C0,12); \
    KRD(GL,2); GAPB(o[0]=__builtin_amdgcn_mfma_f32_32x32x16_bf16(PAF(2),VFR(2),o[0],0,0,0), C1,0); \
    KRD(GL,3); GAPB(o[1]=__builtin_amdgcn_mfma_f32_32x32x16_bf16(PAF(2),VFR(6),o[1],0,0,0), C1,4); \
    GAPB(o[0]=__builtin_amdgcn_mfma_f32_32x32x16_bf16(PAF(3),VFR(3),o[0],0,0,0), C1,8); \
    GAPB(o[1]=__builtin_amdgcn_mfma_f32_32x32x16_bf16(PAF(3),VFR(7),o[1],0,0,0), C1,12); \
    }while(0)
  int t=1;
  for(;t+5<NT;t+=2){
    STEP(pB0,pB1,pA0,pA1,t,true,true,true);     WAIT_BAR(2); RESC(); ROT();
    STEP(pA0,pA1,pB0,pB1,t+1,true,true,true);   WAIT_BAR(2); RESC(); ROT();
  }
  #define ENDW(tt) do{ if((tt)+3<NT){WAIT_BAR(2);} else if((tt)+2<NT){WAIT_BAR(1);} else {WAIT_BAR(0);} }while(0)
  for(;t+1<NT;t+=2){
    STEP(pB0,pB1,pA0,pA1,t,(t+3<NT),(t+1<NT),(t+1<NT));       ENDW(t);   RESC(); ROT();
    STEP(pA0,pA1,pB0,pB1,t+1,(t+4<NT),(t+2<NT),(t+2<NT));     ENDW(t+1); RESC(); ROT();
  }
  STEP(pB0,pB1,pA0,pA1,NT-1,false,false,false); RESC();
  { float sacc=pB0[0]+pB0[1]; _Pragma("unroll") for(int r=2;r<16;++r)sacc+=pB0[r]; _Pragma("unroll") for(int r=0;r<16;++r)sacc+=pB1[r]; l_reg+=sacc;
    pw0=(u32x4){PKW(pB0,0),PKW(pB0,2),PKW(pB0,4),PKW(pB0,6)};pw1=(u32x4){PKW(pB0,8),PKW(pB0,10),PKW(pB0,12),PKW(pB0,14)};pw2=(u32x4){PKW(pB1,0),PKW(pB1,2),PKW(pB1,4),PKW(pB1,6)};pw3=(u32x4){PKW(pB1,8),PKW(pB1,10),PKW(pB1,12),PKW(pB1,14)};
    SBAR(); pv(o,vb0+sl_cur,PAF(0),PAF(1),PAF(2),PAF(3)); }
  #undef PKW
  #undef PAF
  #undef VFR
  #undef PIN
  #undef MX3
  #undef GAPA
  #undef GAPB
  #undef EX
  #undef VRD
  #undef KRD
  #undef STEP
  #undef ENDW
  {auto rr=__builtin_amdgcn_permlane32_swap(__float_as_uint(l_reg),__float_as_uint(l_reg),false,false);l_reg=__uint_as_float(rr[0])+__uint_as_float(rr[1]);}
  if(hi==0)wsf[32+r32]=l_reg;asm volatile("s_waitcnt lgkmcnt(0)":::"memory");
  float rli[16];
  #pragma unroll
  for(int r=0;r<16;++r)rli[r]=__builtin_amdgcn_rcpf(wsf[32+crow(r,hi)]);
  bf16*Ow=O+(rowbase+q0+wid*QBLK)*QP+h*D;
  { bf16*stg=(bf16*)(shm+LDS_OST)+wid*2048;
    #pragma unroll
    for(int r=0;r<16;++r){const int orow=crow(r,hi);
      #pragma unroll
      for(int d0=0;d0<2;++d0)stg[orow*64+d0*32+r32]=__float2bfloat16(o[d0][r]*rli[r]);}
    asm volatile("s_waitcnt lgkmcnt(0)":::"memory");
    #pragma unroll
    for(int i=0;i<4;++i){const int row=i*8+(lane>>3),ch=lane&7; const u32x4 v=*(const u32x4*)(stg+row*64+ch*8); ATTN_STORE16(Ow+(long)row*QP+ch*8,v);} }
  asm volatile("s_waitcnt lgkmcnt(0)\n\ts_barrier":::"memory");
  #undef DMA_K
  #undef DMA_V
  #undef START
  #undef RESC
  #undef ROT
}
constexpr int ATTN_LDS_BYTES=LDS_BYTES;
#undef SBAR
#undef WAIT_BAR
}

namespace attn8 {
using bf16=__hip_bfloat16;
using f32x16=__attribute__((ext_vector_type(16)))float;
using u32x4=__attribute__((ext_vector_type(4)))unsigned;
using i32x4=__attribute__((ext_vector_type(4)))int;
using i32x8=__attribute__((ext_vector_type(8)))int;
constexpr int SEQ=4096,NT=SEQ/64,NW=8;
constexpr int NSL=8;
constexpr int LDS_K=0, LDS_V=NSL*4096, LDS_OST=2*NSL*4096, LDS_BYTES=LDS_OST+NW*2048, LDS_SIDE=LDS_BYTES;
constexpr int E8_Q=0x79797979, E8_K=0x7B7B7B7B, E8_V=0x7B7B7B7B, E8_1=0x7F7F7F7F;
constexpr float SQ=64.f*0.125f*1.4426950408889634f, SK=16.f, SV=16.f, SO=64.f;
constexpr int E8_O=0x79797979;
__device__ __forceinline__ int crow(int r,int hi){return (r&3)+8*(r>>2)+4*hi;}
__device__ __forceinline__ void glds16(const void*gsrc,unsigned lds_dst){unsigned keep;
  asm volatile("s_mov_b32 %0, m0\n\ts_mov_b32 m0, %2\n\ts_nop 0\n\tglobal_load_lds_dwordx4 %1, off\n\ts_mov_b32 m0, %0":"=&s"(keep):"v"(gsrc),"s"(lds_dst):"memory");}
__device__ __forceinline__ void glds16s(const void*sbase,unsigned voff,unsigned lds_dst){unsigned keep;
  asm volatile("s_mov_b32 %0, m0\n\ts_mov_b32 m0, %3\n\ts_nop 0\n\tglobal_load_lds_dwordx4 %1, %2\n\ts_mov_b32 m0, %0":"=&s"(keep):"v"(voff),"s"(sbase),"s"(lds_dst):"memory");}
typedef __attribute__((address_space(3))) const char* lds_cptr;
typedef short v4i16_t __attribute__((ext_vector_type(4)));
typedef unsigned u32x2 __attribute__((ext_vector_type(2)));
__device__ __forceinline__ u32x2 vtr(lds_cptr p){ return __builtin_bit_cast(u32x2,__builtin_amdgcn_ds_read_tr16_b64_v4i16((__attribute__((address_space(3))) v4i16_t*)p)); }
__device__ __forceinline__ i32x8 ld32(lds_cptr p0,lds_cptr p1){ return __builtin_shufflevector(*(const __attribute__((address_space(3))) i32x4*)p0,*(const __attribute__((address_space(3))) i32x4*)p1,0,1,2,3,4,5,6,7); }
#define pk2f8(a,b,old,hiw) __builtin_amdgcn_cvt_pk_fp8_f32(a,b,old,hiw)
#define A8_WAIT_BAR(N) asm volatile("s_waitcnt vmcnt(" #N ") lgkmcnt(0)\n\ts_barrier":::"memory")
#define A8_SS_END(allow) do{ const int c_=side.end(lane,allow); if(c_==2){A8_WAIT_BAR(4);} else if(c_==1){A8_WAIT_BAR(3);} else {A8_WAIT_BAR(2);} }while(0)
#define A8_MFMA(A,B,C,SA,SB) __builtin_amdgcn_mfma_scale_f32_32x32x64_f8f6f4(A,B,C,0,0,0,SA,0,SB)

template<int THRL,class Side> __device__ __forceinline__ void attn_unit(Side&side,int b,int h,int qb,bool first,bool has_next,int nb,int nh,int nqb,i32x8&qf,const unsigned char*Q8,const unsigned char*__restrict__ K8,const unsigned char*__restrict__ V8p,bf16*O,char*shm,float sc){
  const int tid=threadIdx.x,lane=tid&63,r32=lane&31,hi=lane>>5; const int wid=__builtin_amdgcn_readfirstlane(tid>>6);
  const long rowbase=(long)b*SEQ; const int q0=qb*256; const int kvh=h>>2;
  sc=__int_as_float(__builtin_amdgcn_readfirstlane(__float_as_int(sc)));
  const unsigned lds0=(unsigned)(uintptr_t)shm;
  const lds_cptr shm3=(lds_cptr)shm;
  const bool kw=wid<4; const int w4=wid&3, P=64*w4+lane;
  const unsigned char*sbase; unsigned soff; long dn;
  { const int hb=P&1,q_=P>>1,l=q_&63,blk=q_>>6,hi_=l>>5,r=l&31,half=hb^((l>>3)&1);
    const int j=P>>3,cs=P&7,c=cs^(((j>>2)&1)<<2);
    const size_t ko=(size_t)(blk*32+r)*256+32*hi_+16*half, vo=((size_t)j*256+8*c)*2;
    sbase=kw?K8+(size_t)rowbase*256+kvh*64:V8p+((size_t)(rowbase/2)*256+kvh*64)*2; soff=(unsigned)(kw?ko:vo);
    const long nrb=(long)nb*SEQ; const int nkvh=nh>>2;
    dn=(nrb-rowbase)*256+(long)(nkvh-kvh)*(kw?64:128); }
  const unsigned dst0=lds0+(kw?LDS_K:LDS_V)+w4*1024; const int ahead=kw?5:3;
  #define A8_DMA(tile,slot) glds16s(sbase+(size_t)(tile)*16384,soff,(unsigned)__builtin_amdgcn_readfirstlane(dst0+(unsigned)(slot)*4096u))
  #define A8_DMA_N(tile,slot) glds16s(sbase+(has_next?dn+(long)(tile)*16384:(long)(NT-1)*16384),soff,(unsigned)__builtin_amdgcn_readfirstlane(dst0+(unsigned)(slot)*4096u))
  if(first){
    int lf=lane; asm volatile("":"+v"(lf)); const unsigned char*qp=Q8+(size_t)(rowbase+q0+wid*32+(lf&31))*1024+h*64+32*(lf>>5);
    qf=__builtin_shufflevector(*(const i32x4*)qp,*(const i32x4*)(qp+16),0,1,2,3,4,5,6,7);
    asm volatile("s_waitcnt vmcnt(0)":"+v"(qf)::"memory");
    A8_DMA(0,0);A8_DMA(1,1);A8_DMA(2,2);A8_DMA(3,3);A8_DMA(kw?4:3,kw?4:3);A8_DMA(kw?5:3,kw?5:3);
  } else { A8_DMA(kw?5:3,kw?5:3); }
  const unsigned kq0=(unsigned)(uintptr_t)shm+LDS_K+lane*32+16*((lane>>3)&1);
  const int q4=(lane&15)>>2,p4=lane&3,g1=(lane>>4)&1,x=(q4>>1)&1;
  const unsigned vq0=(unsigned)(uintptr_t)shm+LDS_V+(2*hi+(q4&1)+4*(q4>>1))*128+(((2*g1+(p4>>1))^(x<<2))*16)+8*(p4&1);
  #define A8_LP(u) ((lds_cptr)(uintptr_t)(u))
  f32x16 o[2],os;o[0]=f32x16{};o[1]=f32x16{};os=f32x16{};
  const f32x16 zero16=f32x16{};
  int one4=0x38383838; asm volatile("":"+s"(one4));
  i32x8 ones=(i32x8){one4,one4,one4,one4,one4,one4,one4,one4};
  asm volatile("":"+v"(ones));
  i32x8 kf[2]; f32x16 pA0,pA1;
  typedef short v2i16_t __attribute__((ext_vector_type(2)));
  #define A8_MFMA_P(A,B,C,SB) __builtin_amdgcn_mfma_scale_f32_32x32x64_f8f6f4(A,B,C,1,0,0,E8_1,0,SB)
  #define A8_KLOAD(slot) do{ const lds_cptr kp0=A8_LP(kq0),kp1=A8_LP(kq0^16u); kf[0]=ld32(kp0+(slot)*4096,kp1+(slot)*4096); kf[1]=ld32(kp0+(slot)*4096+2048,kp1+(slot)*4096+2048); }while(0)
  #define A8_CV(E,i,hiw,old) __builtin_amdgcn_cvt_scalef32_pk_bf8_f32(old,E[i],E[(i)+1],sc,hiw)
  #define A8_PACK(pw,E0,E1) do{ v2i16_t u0_,u1_,u2_,u3_,u4_,u5_,u6_,u7_; asm volatile("":"=v"(u0_),"=v"(u1_),"=v"(u2_),"=v"(u3_),"=v"(u4_),"=v"(u5_),"=v"(u6_),"=v"(u7_)); \
      u0_=A8_CV(E0,0,false,u0_);u0_=A8_CV(E0,2,true,u0_); u1_=A8_CV(E0,4,false,u1_);u1_=A8_CV(E0,6,true,u1_); u2_=A8_CV(E0,8,false,u2_);u2_=A8_CV(E0,10,true,u2_); u3_=A8_CV(E0,12,false,u3_);u3_=A8_CV(E0,14,true,u3_); \
      u4_=A8_CV(E1,0,false,u4_);u4_=A8_CV(E1,2,true,u4_); u5_=A8_CV(E1,4,false,u5_);u5_=A8_CV(E1,6,true,u5_); u6_=A8_CV(E1,8,false,u6_);u6_=A8_CV(E1,10,true,u6_); u7_=A8_CV(E1,12,false,u7_);u7_=A8_CV(E1,14,true,u7_); \
      pw=(i32x8){__builtin_bit_cast(int,u0_),__builtin_bit_cast(int,u1_),__builtin_bit_cast(int,u2_),__builtin_bit_cast(int,u3_),__builtin_bit_cast(int,u4_),__builtin_bit_cast(int,u5_),__builtin_bit_cast(int,u6_),__builtin_bit_cast(int,u7_)}; }while(0)
  #define A8_VLOAD(vf0,vf1,slot) do{ const lds_cptr va_=A8_LP(vq0)+(slot)*4096, vb_=A8_LP(vq0^64u)+(slot)*4096; \
      const u32x2 a0=vtr(va_),a1=vtr(va_+1024),a2=vtr(va_+2048),a3=vtr(va_+3072),b0=vtr(vb_),b1=vtr(vb_+1024),b2=vtr(vb_+2048),b3=vtr(vb_+3072); \
      vf0=(i32x8){(int)a0.x,(int)a0.y,(int)a1.x,(int)a1.y,(int)a2.x,(int)a2.y,(int)a3.x,(int)a3.y}; vf1=(i32x8){(int)b0.x,(int)b0.y,(int)b1.x,(int)b1.y,(int)b2.x,(int)b2.y,(int)b3.x,(int)b3.y}; }while(0)
  if(first){ A8_WAIT_BAR(5); }
  A8_KLOAD(0);
  pA0=A8_MFMA(kf[0],qf,zero16,E8_K,E8_Q); pA1=A8_MFMA(kf[1],qf,zero16,E8_K,E8_Q);
  #define A8_MPART_S(t,sv,sk) do{ i32x8 vf0,vf1,pw; \
    A8_VLOAD(vf0,vf1,sv); \
    A8_PACK(pw,pA0,pA1); \
    pA0=A8_MFMA(kf[0],qf,zero16,E8_K,E8_Q); pA1=A8_MFMA(kf[1],qf,zero16,E8_K,E8_Q); \
    A8_KLOAD(sk);                                       \
    { const int ta_=(t)+ahead; if(ta_<NT){ A8_DMA(ta_,ta_&(NSL-1)); } else { A8_DMA_N(ta_-NT,ta_&(NSL-1)); } } \
    o[0]=A8_MFMA_P(pw,vf0,o[0],E8_V); o[1]=A8_MFMA_P(pw,vf1,o[1],E8_V); os=A8_MFMA_P(pw,ones,os,E8_1); }while(0)
  #define A8_MPART(t) A8_MPART_S(t,((t)-1)&(NSL-1),((t)+1)&(NSL-1))
  #define A8_VPART() do{ _Pragma("unroll") for(int r=0;r<16;++r){pA0[r]=__builtin_amdgcn_exp2f(pA0[r]);pA1[r]=__builtin_amdgcn_exp2f(pA1[r]);} asm volatile("":"+v"(pA0),"+v"(pA1),"+v"(o[0]),"+v"(o[1]),"+v"(os)); }while(0)
  if(wid<4){
    A8_VPART();
    if(first){ A8_WAIT_BAR(2); }
    A8_KLOAD(1);
#pragma unroll 1
    for(int t0=1;t0<=NT-15;t0+=8){
      side.begin(lane); A8_MPART_S(t0,0,2); A8_VPART(); A8_MPART_S(t0+1,1,3); A8_VPART(); A8_SS_END(true);
      side.begin(lane); A8_MPART_S(t0+2,2,4); A8_VPART(); A8_MPART_S(t0+3,3,5); A8_VPART(); A8_SS_END(true);
      side.begin(lane); A8_MPART_S(t0+4,4,6); A8_VPART(); A8_MPART_S(t0+5,5,7); A8_VPART(); A8_SS_END(true);
      side.begin(lane); A8_MPART_S(t0+6,6,0); A8_VPART(); A8_MPART_S(t0+7,7,1); A8_VPART(); A8_SS_END(true);
    }
    side.begin(lane); A8_MPART(NT-7); A8_VPART(); A8_MPART(NT-6); A8_VPART(); A8_SS_END(true);
    side.begin(lane); A8_MPART(NT-5); A8_VPART(); A8_MPART(NT-4); A8_VPART(); A8_SS_END(false);
    side.begin(lane); A8_MPART(NT-3); A8_VPART(); A8_MPART(NT-2); A8_VPART(); A8_SS_END(false);
    side.begin(lane); A8_MPART(NT-1); A8_VPART(); A8_SS_END(false);
  } else {
    if(first){ A8_WAIT_BAR(2); }
    A8_KLOAD(1);
#pragma unroll 1
    for(int t0=1;t0<=NT-15;t0+=8){
      side.begin(lane); A8_VPART(); A8_MPART_S(t0,0,2); A8_VPART(); A8_MPART_S(t0+1,1,3); A8_SS_END(true);
      side.begin(lane); A8_VPART(); A8_MPART_S(t0+2,2,4); A8_VPART(); A8_MPART_S(t0+3,3,5); A8_SS_END(true);
      side.begin(lane); A8_VPART(); A8_MPART_S(t0+4,4,6); A8_VPART(); A8_MPART_S(t0+5,5,7); A8_SS_END(true);
      side.begin(lane); A8_VPART(); A8_MPART_S(t0+6,6,0); A8_VPART(); A8_MPART_S(t0+7,7,1); A8_SS_END(true);
    }
    side.begin(lane); A8_VPART(); A8_MPART(NT-7); A8_VPART(); A8_MPART(NT-6); A8_SS_END(true);
    side.begin(lane); A8_VPART(); A8_MPART(NT-5); A8_VPART(); A8_MPART(NT-4); A8_SS_END(false);
    side.begin(lane); A8_VPART(); A8_MPART(NT-3); A8_VPART(); A8_MPART(NT-2); A8_SS_END(false);
    side.begin(lane); A8_VPART(); A8_MPART(NT-1); A8_SS_END(false);
    A8_VPART();
  }
  i32x8 qn=qf;
  if(has_next){ int lq=lane; asm volatile("":"+v"(lq)); const unsigned char*qp=Q8+(size_t)((long)nb*SEQ+nqb*256+wid*32+(lq&31))*1024+nh*64+32*(lq>>5);
    qn=__builtin_shufflevector(*(const i32x4*)qp,*(const i32x4*)(qp+16),0,1,2,3,4,5,6,7); }
  { i32x8 vf0,vf1,pw; A8_VLOAD(vf0,vf1,(NT-1)&(NSL-1)); A8_PACK(pw,pA0,pA1);
    o[0]=A8_MFMA_P(pw,vf0,o[0],E8_V); o[1]=A8_MFMA_P(pw,vf1,o[1],E8_V); os=A8_MFMA_P(pw,ones,os,E8_1); }
  int lane2=lane; asm volatile("":"+v"(lane2)); const int r32b=lane2&31,hib=lane2>>5;
  float rli[16];
  #pragma unroll
  for(int r=0;r<16;++r)rli[r]=__builtin_amdgcn_rcpf(os[r]);
  unsigned char*Ow=(unsigned char*)O+(size_t)(rowbase+q0+wid*32)*1024+h*64;
  { unsigned char*stg=(unsigned char*)(shm+LDS_OST)+wid*2048;
    #pragma unroll
    for(int r=0;r<16;r+=2){
      #pragma unroll
      for(int d0=0;d0<2;++d0){ const int w_=__builtin_amdgcn_cvt_pk_fp8_f32(__builtin_fminf(__builtin_fmaxf(o[d0][r]*rli[r]*SO,-448.f),448.f),__builtin_fminf(__builtin_fmaxf(o[d0][r+1]*rli[r+1]*SO,-448.f),448.f),0,false);
        stg[crow(r,hib)*64+d0*32+r32b]=(unsigned char)(w_&0xff); stg[crow(r+1,hib)*64+d0*32+r32b]=(unsigned char)((w_>>8)&0xff); } }
    asm volatile("s_waitcnt lgkmcnt(0)":::"memory");
    #pragma unroll
    for(int i=0;i<2;++i){const int row=i*16+(lane2>>2),ch=lane2&3; const u32x4 v=*(const u32x4*)(stg+row*64+ch*16); *(u32x4*)(Ow+(size_t)row*1024+ch*16)=v;} }
  qf=qn;
  asm volatile("s_waitcnt vmcnt(0) lgkmcnt(0)\n\ts_barrier":"+v"(qf)::"memory");
  #undef A8_DMA
  #undef A8_LP
  #undef A8_DMA_N
  #undef A8_KLOAD
  #undef A8_MFMA_P
  #undef A8_MPART
  #undef A8_MPART_S
  #undef A8_VPART
  #undef A8_CV
  #undef A8_PACK
  #undef A8_VLOAD
}
constexpr int ATTN_LDS_BYTES=LDS_BYTES;
#undef A8_WAIT_BAR
#undef A8_MFMA
}

constexpr int NWAVES = 8;
constexpr int BATCH = 8, SEQ = 4096, T = BATCH * SEQ, D = 1024, NE = 16, CAP = 512, FF = 2048, NQKV = 1536, MROWS = BATCH * NE * CAP;
constexpr float EPS = 1e-6f;
constexpr int N_PHASES = 17;
constexpr int N_LAUNCHES = MK_N_LAUNCHES;

constexpr size_t MiB = 1u << 20;
constexpr size_t WS_CTL = 0, CTL_ZERO_BYTES = 1 * MiB;
constexpr size_t WS_ROPE = 1 * MiB;
constexpr size_t WS_AFF = 2 * MiB;
constexpr size_t WS_IDX = 4 * MiB;
constexpr size_t WS_GATE = 4 * MiB + 512 * 1024;
constexpr size_t WS_INV = 5 * MiB;
constexpr size_t WS_WIN = 8 * MiB, WS_WOUT = 14 * MiB, WS_WQKV = 16 * MiB, WS_WO = 20 * MiB;
constexpr size_t WS_WGU = 32 * MiB;
constexpr size_t WS_WD = 288 * MiB;
constexpr size_t WS_XN = 416 * MiB;
constexpr size_t WS_BIG = 480 * MiB;
constexpr size_t WS_Y = 736 * MiB;
constexpr size_t WS_XN8 = 864 * MiB;
constexpr size_t WS_HB = 896 * MiB;
constexpr size_t WS_END = 960 * MiB;
constexpr int ESZ = MOE_FP8 ? 1 : 2;
constexpr float SC_W = 1024.f, SC_X = 16.f, SC_H = 8.f, SC_Y = 64.f;
constexpr int E8_W = 0x75757575, E8_X = 0x7B7B7B7B, E8_H = 0x7C7C7C7C;
constexpr float WG_FOLD = -1.4426950408889634f, WU_FOLD = -(SC_H / 8.f) / 1.4426950408889634f; constexpr int E8_WU = 0x78787878;
constexpr int CW_TMO = 0, CW_CODE = 1, CW_BAR = 4096, CW_CONV = 16384, CW_CONV2 = 16448;

constexpr int RING_OFF = 0, RING_BYTES = 131072;
constexpr int GIDX_OFF = RING_BYTES, GIDX_BYTES = 16384;
constexpr int LDSCTL_OFF = GIDX_OFF + GIDX_BYTES, MISC_OFF = LDSCTL_OFF + 320;
constexpr int LDS_BYTES = LDSCTL_OFF + 512;

#define GAS __attribute__((address_space(1)))
#define LAS __attribute__((address_space(3)))
typedef unsigned short bf16;
typedef unsigned v4u __attribute__((ext_vector_type(4)));
typedef unsigned v2u __attribute__((ext_vector_type(2)));
typedef float f32x4 __attribute__((ext_vector_type(4)));
typedef GAS unsigned gu32;
#define RLX_AGENT __ATOMIC_RELAXED, __HIP_MEMORY_SCOPE_AGENT
#define LDS_WAIT() asm volatile("s_waitcnt lgkmcnt(0)" ::: "memory")
#define VM_WAIT() asm volatile("s_waitcnt vmcnt(0)" ::: "memory")
__device__ __forceinline__ unsigned f2bf(float f) { unsigned u = __builtin_bit_cast(unsigned, f); return (u + 0x7fffu + ((u >> 16) & 1u)) >> 16; }
__device__ __forceinline__ unsigned pk2(float lo, float hi) { return f2bf(lo) | (f2bf(hi) << 16); }
__device__ __forceinline__ float bflo(unsigned w) { return __uint_as_float(w << 16); }
__device__ __forceinline__ float bfhi(unsigned w) { return __uint_as_float(w & 0xffff0000u); }

#define XB_TMO      128
#define XB_XCNT(j)  (256  + 64 * (j))
#define XB_XSUB(j)  (1280 + 64 * (j))
#define XB_XGEN(j)  (2304 + 64 * (j))
#define XB_TOP      3328
#define XB_TOPGEN   3392
#define XCD_BAR_WORDS 3456
#define XB_SPIN_CAP (1u << 18)

__device__ __forceinline__ unsigned xb_ld(unsigned* p)              { return __hip_atomic_load(p, __ATOMIC_RELAXED, __HIP_MEMORY_SCOPE_AGENT); }
__device__ __forceinline__ unsigned xb_add(unsigned* p, unsigned v) { return __hip_atomic_fetch_add(p, v, __ATOMIC_RELAXED, __HIP_MEMORY_SCOPE_AGENT); }
__device__ __forceinline__ unsigned xb_xcc_id() { return (unsigned)__builtin_amdgcn_s_getreg((3 << 11) | 20) & 0xFu; }
#define XB_SPIN(cond, bar) do { unsigned _sp = 0; while (cond) { __builtin_amdgcn_s_sleep(1); \
    if ((++_sp & 255u) == 0u) { if (xb_ld(&(bar)[XB_TMO])) break; if (_sp > XB_SPIN_CAP) { atomicAdd(&(bar)[XB_TMO], 1u); break; } } } } while (0)

struct XcdBarrier { unsigned* bar; unsigned x; volatile LAS unsigned* st; };
__device__ __forceinline__ XcdBarrier xcd_barrier_post(unsigned* bar, volatile LAS unsigned* st) {
    XcdBarrier b; b.bar = bar; b.x = xb_xcc_id(); b.st = st;
    if (threadIdx.x == 0) (void)xb_add(&bar[XB_XCNT(b.x)], 1u);
    return b;
}
__device__ __forceinline__ void xcd_barrier_complete(unsigned* bar, unsigned x, unsigned& nloc, unsigned& nx) {
    const unsigned G = gridDim.x * gridDim.y * gridDim.z;
    unsigned sum, cnt, mine, sp = 0u;
    for (;;) {
        sum = 0u; cnt = 0u; mine = 0u;
#pragma unroll
        for (unsigned j = 0; j < 16; ++j) { const unsigned c = xb_ld(&bar[XB_XCNT(j)]); sum += c; cnt += (c > 0u) ? 1u : 0u; mine = (j == x) ? c : mine; }
        if (sum == G) break;
        __builtin_amdgcn_s_sleep(1);
        if ((++sp & 255u) == 0u) { if (xb_ld(&bar[XB_TMO])) break; if (sp > XB_SPIN_CAP) { atomicAdd(&bar[XB_TMO], 1u); break; } }
    }
    nloc = mine > 0u ? mine : 1u; nx = cnt > 0u ? cnt : 1u;
}
__device__ __forceinline__ void xcd_barrier(const XcdBarrier& b) {
    asm volatile("s_waitcnt vmcnt(0)" ::: "memory");
    __syncthreads();
    if (threadIdx.x == 0) {
        unsigned* bar = b.bar;
        __builtin_amdgcn_s_waitcnt(0);
        unsigned nloc = b.st[0], nx = b.st[1];
        if (nloc == 0u) { xcd_barrier_complete(bar, b.x, nloc, nx); b.st[0] = nloc; b.st[1] = nx; }
        const unsigned old = xb_add(&bar[XB_XSUB(b.x)], 1u);
        const unsigned gen = old / nloc;
        if (old + 1u == (gen + 1u) * nloc) {
            __builtin_amdgcn_fence(__ATOMIC_RELEASE, "agent");
            asm volatile("s_waitcnt vmcnt(0)" ::: "memory");
            const unsigned og = xb_add(&bar[XB_TOP], 1u);
            const unsigned tg = og / nx;
            if (og + 1u == (tg + 1u) * nx) xb_add(&bar[XB_TOPGEN], 1u);
            else XB_SPIN(xb_ld(&bar[XB_TOPGEN]) == tg, bar);
            __builtin_amdgcn_fence(__ATOMIC_ACQUIRE, "agent");
            xb_add(&bar[XB_XGEN(b.x)], 1u);
            asm volatile("s_waitcnt vmcnt(0)" ::: "memory");
        } else {
            XB_SPIN(xb_ld(&bar[XB_XGEN(b.x)]) == gen, bar);
            __builtin_amdgcn_fence(__ATOMIC_ACQUIRE, "agent");
            asm volatile("s_waitcnt vmcnt(0)" ::: "memory");
        }
    }
    __syncthreads();
}

struct Frame {
    LAS unsigned char* lds;
    volatile LAS unsigned* MISC;
    gu32* ctl;
    int tid, lane, wave;
    int vcu, G;
};

__device__ __forceinline__ float wave_sum(float v) {
#pragma unroll
    for (int o = 1; o < 64; o <<= 1) v += __shfl_xor(v, o);
    return v;
}

template <int MAP> __device__ __forceinline__ int rowmap(int n) {
    if (MAP == 0) return n;
    if (MAP == 4) { if (n < 1024) return n; const int hsel = n >= 2048, ch = n - 1024 - 1024 * hsel; return 1024 + ((ch >> 7) << 8) + 128 * hsel + (ch & 127); }
    if (MAP == 2) return ((n >> 7) << 8) + (n & 127);
    if (MAP == 3) return ((n >> 7) << 8) + 128 + (n & 127);
    if (n < 1280) {
        const int h = n >> 6, d = n & 63, bj = d >> 5, dp = d & 31, nn = dp >> 4, fq = (dp & 15) >> 2, j = dp & 3, i = 8 * fq + 4 * nn + j;
        const int pn = (n < 1024) ? (h >> 2) : 4, wc = h & 3;
        return pn * 256 + bj * 128 + wc * 32 + i;
    }
    const int h = (n - 1280) >> 6, d = n & 63, bj = d >> 5, dp = d & 31;
    return 5 * 256 + bj * 128 + h * 32 + dp;
}
template <int MAP> __device__ __forceinline__ void tr_item(const float* __restrict__ W, int K, int N, bf16* __restrict__ WT, LAS float* scr, int kb, int nb, int lane) {
    const int k0 = 64 * kb, n0 = 64 * nb, c4 = lane & 15, rr = lane >> 4;
    f32x4 v[16];
#pragma unroll
    for (int i = 0; i < 16; ++i) v[i] = *(const GAS f32x4*)(W + (size_t)(k0 + 4 * i + rr) * N + n0 + 4 * c4);
#pragma unroll
    for (int i = 0; i < 16; ++i) { LAS float* s = scr + (4 * i + rr) * 65 + 4 * c4; s[0] = v[i].x; s[1] = v[i].y; s[2] = v[i].z; s[3] = v[i].w; }
    LDS_WAIT(); asm volatile("" ::: "memory");
    const int c = lane & 7;
#pragma unroll
    for (int j = 0; j < 8; ++j) { const int nn = (lane >> 3) + 8 * j; const LAS float* s = scr + (8 * c) * 65 + nn;
        v4u o; o.x = pk2(s[0 * 65], s[1 * 65]); o.y = pk2(s[2 * 65], s[3 * 65]); o.z = pk2(s[4 * 65], s[5 * 65]); o.w = pk2(s[6 * 65], s[7 * 65]);
        *(GAS v4u*)(WT + (size_t)rowmap<MAP>(n0 + nn) * K + k0 + 8 * c) = o; }
    LDS_WAIT(); asm volatile("" ::: "memory");
}
template <int MAP> __device__ __forceinline__ void tr_item_f8(const float* __restrict__ W, int K, int N, unsigned char* __restrict__ WT, LAS float* scr, int kb, int nb, int lane, float sc) {
    const int k0 = 64 * kb, n0 = 64 * nb, c4 = lane & 15, rr = lane >> 4;
    f32x4 v[16];
#pragma unroll
    for (int i = 0; i < 16; ++i) v[i] = *(const GAS f32x4*)(W + (size_t)(k0 + 4 * i + rr) * N + n0 + 4 * c4);
#pragma unroll
    for (int i = 0; i < 16; ++i) { LAS float* s = scr + (4 * i + rr) * 65 + 4 * c4; s[0] = v[i].x; s[1] = v[i].y; s[2] = v[i].z; s[3] = v[i].w; }
    LDS_WAIT(); asm volatile("" ::: "memory");
    const int c = lane & 3;
#pragma unroll
    for (int j = 0; j < 4; ++j) { const int nn = (lane >> 2) + 16 * j; const LAS float* s = scr + (16 * c) * 65 + nn;
        v4u o; o.x = pg8::pk4_fp8(s[0 * 65] * sc, s[1 * 65] * sc, s[2 * 65] * sc, s[3 * 65] * sc); o.y = pg8::pk4_fp8(s[4 * 65] * sc, s[5 * 65] * sc, s[6 * 65] * sc, s[7 * 65] * sc);
        o.z = pg8::pk4_fp8(s[8 * 65] * sc, s[9 * 65] * sc, s[10 * 65] * sc, s[11 * 65] * sc); o.w = pg8::pk4_fp8(s[12 * 65] * sc, s[13 * 65] * sc, s[14 * 65] * sc, s[15 * 65] * sc);
        *(GAS v4u*)(WT + (size_t)rowmap<MAP>(n0 + nn) * K + k0 + 16 * c) = o; }
    LDS_WAIT(); asm volatile("" ::: "memory");
}
__device__ __forceinline__ float clamp448(float x) { return __builtin_fminf(__builtin_fmaxf(x, -448.f), 448.f); }
struct Tr8Item { const float* src; unsigned char* dst; int K, N, gu  , add, kb, nb; float sc; };
constexpr int TR8_PER_LAYER = 3 * 16 * 512;
__device__ __forceinline__ Tr8Item tr8_decode(int layer, int q_, const float* w_gate, const float* w_up, const float* w_down, unsigned char* WGU8, unsigned char* WD8) {
    Tr8Item t; const int which = q_ >> 13, mt = layer * 16 + ((q_ >> 9) & 15), q = q_ & 511, sub = q & 7, sup = q >> 3;
    if (which < 2) { const bool up = which == 1; t.src = (up ? w_up : w_gate) + (size_t)mt * 1024 * 2048; t.dst = WGU8 + (size_t)mt * 4096 * 1024; t.K = 1024; t.N = 2048; t.gu = 1; t.add = up ? 128 : 0; t.sc = SC_W * (up ? WU_FOLD : WG_FOLD);
        t.nb = 4 * (sup & 7) + (sub & 3); t.kb = 2 * (sup >> 3) + (sub >> 2); }
    else { t.src = w_down + (size_t)mt * 2048 * 1024; t.dst = WD8 + (size_t)mt * 1024 * 2048; t.K = 2048; t.N = 1024; t.gu = 0; t.add = 0; t.sc = SC_W; t.nb = 4 * (sup & 3) + (sub & 3); t.kb = 2 * (sup >> 2) + (sub >> 2); }
    return t;
}
__device__ __forceinline__ void tr8_load(const Tr8Item& t, int lane, f32x4 (&va)[8], f32x4 (&vb)[8]) {
    const int k0 = 64 * t.kb, n0 = 64 * t.nb, c4 = lane & 15, rr = lane >> 4;
#pragma unroll
    for (int i = 0; i < 8; ++i) { const float* p = t.src + (size_t)(k0 + 8 * i + 2 * rr) * t.N + n0 + 4 * c4; va[i] = *(const GAS f32x4*)p; vb[i] = *(const GAS f32x4*)(p + t.N); }
}
__device__ __forceinline__ void tr8_store(const Tr8Item& t, int lane, LAS unsigned char* scr) {
    constexpr int PITCH = 160;
    const int k0 = 64 * t.kb, n0 = 64 * t.nb;
    const int g = lane >> 4, i16 = lane & 15, q = i16 >> 2, pp = i16 & 3;
    typedef short v4i16_t __attribute__((ext_vector_type(4)));
#pragma unroll
    for (int s4 = 0; s4 < 4; ++s4) {
        const LAS unsigned char* a0 = scr + (8 * g + q) * PITCH + (16 * s4 + 4 * pp) * 2;
        const v4i16_t r0 = __builtin_amdgcn_ds_read_tr16_b64_v4i16((LAS v4i16_t*)a0), r1 = __builtin_amdgcn_ds_read_tr16_b64_v4i16((LAS v4i16_t*)(a0 + 4 * PITCH));
        const v2u lo = __builtin_bit_cast(v2u, r0), hi = __builtin_bit_cast(v2u, r1);
        v4u o; o.x = lo.x; o.y = lo.y; o.z = hi.x; o.w = hi.y;
        const int n = n0 + 16 * s4 + i16, row = t.gu ? (((n >> 7) << 8) + (n & 127) + t.add) : n;
        __builtin_nontemporal_store(o, (GAS v4u*)(t.dst + (size_t)row * t.K + k0 + 16 * g)); }
}
__device__ __forceinline__ void tr8_store_lean(const Tr8Item& t, int lane, LAS unsigned char* scr) {
    constexpr int PITCH = 160;
    const int k0 = 64 * t.kb, n0 = 64 * t.nb;
    const int g = lane >> 4, i16 = lane & 15, q = i16 >> 2, pp = i16 & 3;
    typedef short v4i16_t __attribute__((ext_vector_type(4)));
#pragma unroll 1
    for (int s4 = 0; s4 < 4; ++s4) {
        const LAS unsigned char* a0 = scr + (8 * g + q) * PITCH + (16 * s4 + 4 * pp) * 2;
        const v4i16_t r0 = __builtin_amdgcn_ds_read_tr16_b64_v4i16((LAS v4i16_t*)a0), r1 = __builtin_amdgcn_ds_read_tr16_b64_v4i16((LAS v4i16_t*)(a0 + 4 * PITCH));
        const v2u lo = __builtin_bit_cast(v2u, r0), hi = __builtin_bit_cast(v2u, r1);
        v4u o; o.x = lo.x; o.y = lo.y; o.z = hi.x; o.w = hi.y;
        const int n = n0 + 16 * s4 + i16, row = t.gu ? (((n >> 7) << 8) + (n & 127) + t.add) : n;
        __builtin_nontemporal_store(o, (GAS v4u*)(t.dst + (size_t)row * t.K + k0 + 16 * g));
        asm volatile("" ::: "memory"); }
}
__device__ __forceinline__ void tr8_finish(const Tr8Item& t, int lane, const f32x4 (&va)[8], const f32x4 (&vb)[8], LAS unsigned char* scr, float sc) {
    constexpr int PITCH = 160;
    const int k0 = 64 * t.kb, n0 = 64 * t.nb, c4 = lane & 15, rr = lane >> 4;
#pragma unroll
    for (int i = 0; i < 8; ++i) { const f32x4 a = va[i] * sc, b = vb[i] * sc; int w0 = 0, w1 = 0;
        w0 = __builtin_amdgcn_cvt_pk_fp8_f32(clamp448(a.x), clamp448(b.x), w0, false); w0 = __builtin_amdgcn_cvt_pk_fp8_f32(clamp448(a.y), clamp448(b.y), w0, true);
        w1 = __builtin_amdgcn_cvt_pk_fp8_f32(clamp448(a.z), clamp448(b.z), w1, false); w1 = __builtin_amdgcn_cvt_pk_fp8_f32(clamp448(a.w), clamp448(b.w), w1, true);
        v2u w; w.x = (unsigned)w0; w.y = (unsigned)w1; *(LAS v2u*)(scr + (4 * i + rr) * PITCH + 8 * c4) = w; }
    LDS_WAIT(); asm volatile("" ::: "memory");
    tr8_store(t, lane, scr);
    LDS_WAIT(); asm volatile("" ::: "memory");
}
__device__ __forceinline__ void rms_row_to_bf16(const float* xrow, const float* g, bf16* orow, int lane) {
    const GAS f32x4* xr = (const GAS f32x4*)xrow + lane; const GAS f32x4* gr = (const GAS f32x4*)g + lane;
    f32x4 v[4]; float s = 0.f;
#pragma unroll
    for (int j = 0; j < 4; ++j) { v[j] = xr[64 * j]; s += (v[j].x * v[j].x + v[j].y * v[j].y) + (v[j].z * v[j].z + v[j].w * v[j].w); }
    const float rs = 1.f / sqrtf(wave_sum(s) * (1.f / D) + EPS);
    GAS v2u* o8 = (GAS v2u*)orow + lane;
#pragma unroll
    for (int j = 0; j < 4; ++j) { const f32x4 gg = gr[64 * j]; v2u w; w.x = pk2(v[j].x * rs * gg.x, v[j].y * rs * gg.y); w.y = pk2(v[j].z * rs * gg.z, v[j].w * rs * gg.w); o8[64 * j] = w; }
}

struct Args { const float* in[15]; float* out; unsigned char* ws; int ph_lo, ph_hi; };

__device__ __forceinline__ void convert_layer(int layer, int first, int end, int gw, int NGW, int lane, LAS unsigned char* scr8, const float* w_gate, const float* w_up, const float* w_down, unsigned char* WGU8, unsigned char* WD8) {
    f32x4 a0[8], b0[8], a1[8], b1[8]; Tr8Item t0, t1;
    int r = first + gw;
    if (r < end) {
        t0 = tr8_decode(layer, r, w_gate, w_up, w_down, WGU8, WD8); tr8_load(t0, lane, a0, b0);
        for (;;) {
            int rn = r + NGW; bool hn = rn < end;
            if (hn) { t1 = tr8_decode(layer, rn, w_gate, w_up, w_down, WGU8, WD8); tr8_load(t1, lane, a1, b1); }
            tr8_finish(t0, lane, a0, b0, scr8, t0.sc);
            if (!hn) break;
            r = rn; rn = r + NGW; hn = rn < end;
            if (hn) { t0 = tr8_decode(layer, rn, w_gate, w_up, w_down, WGU8, WD8); tr8_load(t0, lane, a0, b0); }
            tr8_finish(t1, lane, a1, b1, scr8, t1.sc);
            if (!hn) break;
            r = rn;
        }
    }
}

__device__ __forceinline__ int conv_fetch(Frame& F, int cw) {
    if (F.tid == 0) F.MISC[16] = __hip_atomic_fetch_add((gu32*)(F.ctl + cw), 1u, RLX_AGENT);
    __syncthreads();
    const int v = (int)F.MISC[16];
    __syncthreads();
    return __builtin_amdgcn_readfirstlane(v);
}
__device__ __forceinline__ Tr8Item conv_item(int p, int wave, const float* w_gate, const float* w_up, const float* w_down, unsigned char* WGU8, unsigned char* WD8) {
    constexpr int PL = TR8_PER_LAYER / 8; const int layer = p >= PL ? 1 : 0;
    return tr8_decode(layer, (p - layer * PL) * 8 + wave, w_gate, w_up, w_down, WGU8, WD8);
}
__device__ __forceinline__ void convert_dynamic(Frame& F, int cw, int base, int NP, const float* w_gate, const float* w_up, const float* w_down, unsigned char* WGU8, unsigned char* WD8) {
    LAS unsigned char* scr8 = F.lds + F.wave * 18432;
    f32x4 a0[8], b0[8], a1[8], b1[8]; Tr8Item t0, t1;
    int p = conv_fetch(F, cw);
    if (p >= NP) return;
    t0 = conv_item(base + p, F.wave, w_gate, w_up, w_down, WGU8, WD8); tr8_load(t0, F.lane, a0, b0);
    for (;;) {
        p = conv_fetch(F, cw); bool hn = p < NP;
        if (hn) { t1 = conv_item(base + p, F.wave, w_gate, w_up, w_down, WGU8, WD8); tr8_load(t1, F.lane, a1, b1); }
        tr8_finish(t0, F.lane, a0, b0, scr8, t0.sc);
        if (!hn) break;
        p = conv_fetch(F, cw); hn = p < NP;
        if (hn) { t0 = conv_item(base + p, F.wave, w_gate, w_up, w_down, WGU8, WD8); tr8_load(t0, F.lane, a0, b0); }
        tr8_finish(t1, F.lane, a1, b1, scr8, t1.sc);
        if (!hn) break;
    }
}

struct SideConv {
    const float* w_gate; const float* w_up; const float* w_down; unsigned char* WGU8; unsigned char* WD8;
    LAS unsigned char* sb;
    int gw, NGW, total;
    int gi, gp, ib, pb, iP;
    const float* isrc; int ish;
    float psc;
    __device__ __forceinline__ void init(const float* g_, const float* u_, const float* d_, unsigned char* wgu, unsigned char* wd, LAS unsigned char* sb_, int gw_, int ngw_) {
        w_gate = g_; w_up = u_; w_down = d_; WGU8 = wgu; WD8 = wd; sb = sb_; gw = gw_; NGW = ngw_;
        total = gw_ < TR8_PER_LAYER ? ((TR8_PER_LAYER - 1 - gw_) / ngw_ + 1) * 16 : 0; gi = gp = ib = pb = iP = 0; isrc = g_; ish = 11; psc = 0.f; have = 0; ra = rb = (f32x2_){0.f, 0.f}; }
    __device__ __forceinline__ Tr8Item item(int g) const { return tr8_decode(1, gw + (g >> 4) * NGW, w_gate, w_up, w_down, WGU8, WD8); }
    typedef float f32x2_ __attribute__((ext_vector_type(2)));
    f32x2_ ra, rb; int have;
    __device__ __forceinline__ void preload(int lane_) {
        int lane = lane_; asm volatile("" : "+v"(lane));
        const LAS unsigned char* sl = sb + pb * 1024 + (lane >> 5) * 512 + (lane & 31) * 8;
        ra = *(const LAS f32x2_*)sl; rb = *(const LAS f32x2_*)(sl + 256);
        have = 1;
    }
    __device__ __forceinline__ void convert(int lane_) {
        int lane = lane_; asm volatile("" : "+v"(lane));
        const int i = gp & 15, p = lane >> 5, c2 = lane & 31;
        if (i == 0) { const int which = (gw + (gp >> 4) * NGW) >> 13; psc = SC_W * (which == 0 ? WG_FOLD : which == 1 ? WU_FOLD : 1.f); }
        const float sc = __int_as_float(__builtin_amdgcn_readfirstlane(__float_as_int(psc)));
        const f32x2_ a = ra * sc, b = rb * sc;
        int w = 0;
        w = __builtin_amdgcn_cvt_pk_fp8_f32(clamp448(a.x), clamp448(b.x), w, false); w = __builtin_amdgcn_cvt_pk_fp8_f32(clamp448(a.y), clamp448(b.y), w, true);
        *(LAS unsigned*)(sb + 3072 + (2 * i + p) * 160 + c2 * 4) = (unsigned)w;
        if (i == 15) { const Tr8Item t = item(gp); LDS_WAIT(); asm volatile("" ::: "memory"); tr8_store_lean(t, lane, sb + 3072); LDS_WAIT(); asm volatile("" ::: "memory"); }
        ++gp; pb = pb == 2 ? 0 : pb + 1; have = 0;
    }
    __device__ __forceinline__ void process(int lane) { preload(lane); convert(lane); }
    __device__ __forceinline__ void issue(int lane_) {
        int lane = lane_; asm volatile("" : "+v"(lane));
        if ((gi & 15) == 0) { const Tr8Item t = item(gi); isrc = t.src + (size_t)(64 * t.kb) * t.N + 64 * t.nb; ish = t.N == 2048 ? 11 : 10; }
        attn8::glds16(isrc + (((lane >> 4) << ish) + 4 * (lane & 15)), (unsigned)__builtin_amdgcn_readfirstlane((unsigned)(uintptr_t)sb + (unsigned)ib * 1024u));
        isrc += (size_t)4 << ish; ++gi; ib = ib == 2 ? 0 : ib + 1;
    }
    __device__ __forceinline__ void begin(int lane) { if (have) convert(lane); }
    __device__ __forceinline__ int end(int lane, bool allow) {
        if (gi - gp >= 3) preload(lane);
        if (allow && gi < total && gi - gp <= 2 + have) { issue(lane); const int c = iP ? 2 : 1; iP = 1; return c; }
        iP = 0; return 0;
    }
    __device__ __forceinline__ void flush(int lane) {
        if (have) convert(lane);
        while (gp < gi) process(lane);
        while (gi < total) { issue(lane); VM_WAIT(); process(lane); }
    }
};
struct SideNone { __device__ __forceinline__ void begin(int) {} __device__ __forceinline__ int end(int, bool) { return 0; } };

__device__ __forceinline__ void p0_prologue(Frame& F, const Args& a, unsigned char* ws) {
    LAS float* scr = (LAS float*)(F.lds + F.wave * 18432);
    const int gw = F.vcu * NWAVES + F.wave, NGW = F.G * NWAVES;
    const float* conv_in = a.in[3]; const float* conv_out = a.in[5]; const float* attn_qkv = a.in[6]; const float* attn_out = a.in[9];
    const float* w_gate = a.in[11]; const float* w_up = a.in[12]; const float* w_down = a.in[13];
    bf16* WIN = (bf16*)(ws + WS_WIN); bf16* WOUT = (bf16*)(ws + WS_WOUT); bf16* WQKV = (bf16*)(ws + WS_WQKV); bf16* WO = (bf16*)(ws + WS_WO);
    bf16* WGU = (bf16*)(ws + WS_WGU); bf16* WD = (bf16*)(ws + WS_WD);
    constexpr int I_IN = 16 * 48, I_OUT = 16 * 16, I_QKV = 16 * 24, I_O = 16 * 16, I_G = 32 * 512, I_D = 32 * 512;
    constexpr int NB16 = I_IN + I_OUT + I_QKV + I_O;
    for (int it = gw; it < NB16; it += NGW) {
        int r = it;
        if (r < I_IN) { tr_item<4>(conv_in, 1024, 3072, WIN, scr, r / 48, r % 48, F.lane); continue; } r -= I_IN;
        if (r < I_OUT) { tr_item<0>(conv_out, 1024, 1024, WOUT, scr, r / 16, r % 16, F.lane); continue; } r -= I_OUT;
#if ATTN_FP8
        if (r < I_QKV) { tr_item_f8<1>(attn_qkv, 1024, 1536, (unsigned char*)WQKV, scr, r / 24, r % 24, F.lane, SC_W); continue; } r -= I_QKV;
        tr_item_f8<0>(attn_out, 1024, 1024, (unsigned char*)WO, scr, r / 16, r % 16, F.lane, SC_W);
#else
        if (r < I_QKV) { tr_item<1>(attn_qkv, 1024, 1536, WQKV, scr, r / 24, r % 24, F.lane); continue; } r -= I_QKV;
        tr_item<0>(attn_out, 1024, 1024, WO, scr, r / 16, r % 16, F.lane);
#endif
    }
#if MOE_FP8
    if (P1_CONV > 0 && P1_ALL) { if (F.G <= P1_CONV) { convert_layer(0, 0, TR8_PER_LAYER, gw, NGW, F.lane, (LAS unsigned char*)scr, w_gate, w_up, w_down, (unsigned char*)(ws + WS_WGU), (unsigned char*)(ws + WS_WD)); convert_layer(1, 0, TR8_PER_LAYER, gw, NGW, F.lane, (LAS unsigned char*)scr, w_gate, w_up, w_down, (unsigned char*)(ws + WS_WGU), (unsigned char*)(ws + WS_WD)); } }
    else if (P1_CONV > 0 && ATTN_SIDE) convert_layer(0, F.G > P1_CONV ? P1_SPLIT : 0, TR8_PER_LAYER, gw, NGW, F.lane, (LAS unsigned char*)scr, w_gate, w_up, w_down, (unsigned char*)(ws + WS_WGU), (unsigned char*)(ws + WS_WD));
    else
    for (int rep_ = 0; rep_ < ((P0_REP & 2) ? 2 : 1); ++rep_)
    {
        unsigned char* WGU8 = (unsigned char*)(ws + WS_WGU); unsigned char* WD8 = (unsigned char*)(ws + WS_WD); LAS unsigned char* scr8 = (LAS unsigned char*)scr;
        constexpr int N8 = ATTN_SIDE ? TR8_PER_LAYER : 2 * TR8_PER_LAYER;
        f32x4 a0[8], b0[8], a1[8], b1[8]; Tr8Item t0, t1;
        int r = gw;
        if (r < N8) {
            t0 = tr8_decode(ATTN_SIDE ? 0 : r / TR8_PER_LAYER, ATTN_SIDE ? r : r % TR8_PER_LAYER, w_gate, w_up, w_down, WGU8, WD8); tr8_load(t0, F.lane, a0, b0);
            for (;;) {
                int rn = r + NGW; bool hn = rn < N8;
                if (hn) { t1 = tr8_decode(ATTN_SIDE ? 0 : rn / TR8_PER_LAYER, ATTN_SIDE ? rn : rn % TR8_PER_LAYER, w_gate, w_up, w_down, WGU8, WD8); tr8_load(t1, F.lane, a1, b1); }
                tr8_finish(t0, F.lane, a0, b0, scr8, t0.sc);
                if (!hn) break;
                r = rn; rn = r + NGW; hn = rn < N8;
                if (hn) { t0 = tr8_decode(ATTN_SIDE ? 0 : rn / TR8_PER_LAYER, ATTN_SIDE ? rn : rn % TR8_PER_LAYER, w_gate, w_up, w_down, WGU8, WD8); tr8_load(t0, F.lane, a0, b0); }
                tr8_finish(t1, F.lane, a1, b1, scr8, t1.sc);
                if (!hn) break;
                r = rn;
            }
        }
    }
#else
    for (int it = gw; it < 2 * I_G + I_D; it += NGW) {
        int r = it;
        if (r < I_G) { const int mt = r >> 9, q = r & 511; tr_item<2>(w_gate + (size_t)mt * 1024 * 2048, 1024, 2048, WGU + (size_t)mt * 4096 * 1024, scr, q >> 5, q & 31, F.lane); continue; } r -= I_G;
        if (r < I_G) { const int mt = r >> 9, q = r & 511; tr_item<3>(w_up + (size_t)mt * 1024 * 2048, 1024, 2048, WGU + (size_t)mt * 4096 * 1024, scr, q >> 5, q & 31, F.lane); continue; } r -= I_G;
        { const int mt = r >> 9, q = r & 511; tr_item<0>(w_down + (size_t)mt * 2048 * 1024, 2048, 1024, WD + (size_t)mt * 1024 * 2048, scr, q >> 4, q & 15, F.lane); }
    }
#endif
    { float* cosT = (float*)(ws + WS_ROPE); float* sinT = cosT + 1024;
      for (int i = blockIdx.x * 512 + F.tid; i < 1024; i += F.G * 512) { const int pos = i >> 4, fi = i & 15;
          const float inv = powf(10000.0f, -(float)(2 * fi) / 32.0f); const float ang = (float)pos * inv; cosT[i] = cosf(ang); sinT[i] = sinf(ang); } }
    for (int rep_ = 0; rep_ < ((P0_REP & 4) ? 2 : 1); ++rep_)
    { const float* x = a.in[0]; const float* g = a.in[1]; bf16* XN = (bf16*)(ws + WS_XN); const int lane = F.lane;
      f32x4 gv[4];
#pragma unroll
      for (int j = 0; j < 4; ++j) gv[j] = *(const GAS f32x4*)(g + 4 * lane + 256 * j);
      for (int m0 = gw * 4; m0 < T; m0 += NGW * 4) {
          f32x4 v[4][4];
#pragma unroll
          for (int r = 0; r < 4; ++r)
#pragma unroll
              for (int j = 0; j < 4; ++j) v[r][j] = *(const GAS f32x4*)(x + (size_t)(m0 + r) * D + 4 * lane + 256 * j);
#pragma unroll
          for (int r = 0; r < 4; ++r) { float ss = 0.f;
#pragma unroll
              for (int j = 0; j < 4; ++j) ss += (v[r][j].x * v[r][j].x + v[r][j].y * v[r][j].y) + (v[r][j].z * v[r][j].z + v[r][j].w * v[r][j].w);
              const float rs = 1.f / sqrtf(wave_sum(ss) * (1.f / D) + EPS);
              GAS v2u* o8 = (GAS v2u*)(XN + (size_t)(m0 + r) * D) + lane;
#pragma unroll
              for (int j = 0; j < 4; ++j) { const f32x4 y = v[r][j] * rs * gv[j]; v2u w; w.x = pk2(y.x, y.y); w.y = pk2(y.z, y.w); o8[64 * j] = w; } }
      } }
}

__device__ __forceinline__ void ld8(const bf16* p, float (&o)[8]) { const v4u w = *(const GAS v4u*)p; o[0] = bflo(w.x); o[1] = bfhi(w.x); o[2] = bflo(w.y); o[3] = bfhi(w.y); o[4] = bflo(w.z); o[5] = bfhi(w.z); o[6] = bflo(w.w); o[7] = bfhi(w.w); }
__device__ __forceinline__ void conv_phase(Frame& F, const bf16* BU, const float* cw, bf16* Z) {
    constexpr int R = 32;
    const int gw = F.vcu * NWAVES + F.wave, NGW = F.G * NWAVES;
    for (int item = gw; item < (T / R) * 2; item += NGW) {
        const int chunk = item >> 1, half = item & 1, t0 = chunk * R, ch = half * 512 + F.lane * 8, s0 = t0 & (SEQ - 1);
        float w0[8], w1[8], w2[8];
        { const f32x4 a0 = *(const GAS f32x4*)(cw + ch), a1 = *(const GAS f32x4*)(cw + ch + 4), b0 = *(const GAS f32x4*)(cw + 1024 + ch), b1 = *(const GAS f32x4*)(cw + 1024 + ch + 4), c0 = *(const GAS f32x4*)(cw + 2048 + ch), c1 = *(const GAS f32x4*)(cw + 2048 + ch + 4);
#pragma unroll
          for (int q = 0; q < 4; ++q) { w0[q] = a0[q]; w0[4 + q] = a1[q]; w1[q] = b0[q]; w1[4 + q] = b1[q]; w2[q] = c0[q]; w2[4 + q] = c1[q]; } }
        const bf16* pb = BU + (size_t)t0 * 2048 + ch; const bf16* pu = pb + 1024;
        float up[8], uc[8], un[8];
        if (s0 > 0) ld8(pu - 2048, up);
        else {
#pragma unroll
            for (int q = 0; q < 8; ++q) up[q] = 0.f; }
        ld8(pu, uc);
#pragma unroll 8
        for (int i = 0; i < R; ++i) {
            if (s0 + i + 1 < SEQ) ld8(pu + (size_t)(i + 1) * 2048, un);
            else {
#pragma unroll
                for (int q = 0; q < 8; ++q) un[q] = 0.f; }
            float bv[8]; ld8(pb + (size_t)i * 2048, bv);
            float z[8];
#pragma unroll
            for (int q = 0; q < 8; ++q) z[q] = bv[q] * (w0[q] * up[q] + w1[q] * uc[q] + w2[q] * un[q]);
            v4u o; o.x = pk2(z[0], z[1]); o.y = pk2(z[2], z[3]); o.z = pk2(z[4], z[5]); o.w = pk2(z[6], z[7]);
            __builtin_nontemporal_store(o, (GAS v4u*)(Z + (size_t)(t0 + i) * 1024 + ch));
#pragma unroll
            for (int q = 0; q < 8; ++q) { up[q] = uc[q]; uc[q] = un[q]; }
        }
    }
}

__device__ __forceinline__ void router_phase(Frame& F, const bf16* H, const float* gain, const float* wrt  , bf16* XN, float* AFF) {
    LAS float* wl = (LAS float*)(F.lds + RING_OFF);
    const int gw = F.vcu * NWAVES + F.wave, NGW = F.G * NWAVES, lane = F.lane;
    v2u xr[4][4];
    if (gw * 4 < T) {
#pragma unroll
        for (int r = 0; r < 4; ++r)
#pragma unroll
            for (int j = 0; j < 4; ++j) xr[r][j] = *(const GAS v2u*)(H + (size_t)(gw * 4 + r) * D + 4 * lane + 256 * j); }
    f32x4 gv[4];
#pragma unroll
    for (int j = 0; j < 4; ++j) gv[j] = *(const GAS f32x4*)(gain + 4 * lane + 256 * j);
    for (int i = F.tid; i < 4096; i += NWAVES * 64) { const int k = i >> 2, e4 = i & 3; const f32x4 v = *(const GAS f32x4*)(wrt + k * 16 + 4 * e4);
        wl[(4 * e4 + 0) * 1024 + k] = v.x; wl[(4 * e4 + 1) * 1024 + k] = v.y; wl[(4 * e4 + 2) * 1024 + k] = v.z; wl[(4 * e4 + 3) * 1024 + k] = v.w; }
    __syncthreads();
    typedef float f32x2 __attribute__((ext_vector_type(2)));
    for (int m0 = gw * 4; m0 < T; m0 += NGW * 4) {
        f32x2 xp[2][4][4];
#pragma unroll
        for (int rp = 0; rp < 2; ++rp)
#pragma unroll
            for (int j = 0; j < 4; ++j) { const v2u w0 = xr[2 * rp][j], w1 = xr[2 * rp + 1][j];
                xp[rp][j][0] = (f32x2){bflo(w0.x), bflo(w1.x)}; xp[rp][j][1] = (f32x2){bfhi(w0.x), bfhi(w1.x)}; xp[rp][j][2] = (f32x2){bflo(w0.y), bflo(w1.y)}; xp[rp][j][3] = (f32x2){bfhi(w0.y), bfhi(w1.y)}; }
        { const int m1 = m0 + NGW * 4;
          if (m1 < T) {
#pragma unroll
            for (int r = 0; r < 4; ++r)
#pragma unroll
                for (int j = 0; j < 4; ++j) xr[r][j] = *(const GAS v2u*)(H + (size_t)(m1 + r) * D + 4 * lane + 256 * j); } }
#pragma unroll
        for (int rp = 0; rp < 2; ++rp) {
            f32x2 s2 = (f32x2){0.f, 0.f};
#pragma unroll
            for (int j = 0; j < 4; ++j)
#pragma unroll
                for (int c = 0; c < 4; ++c) s2 += xp[rp][j][c] * xp[rp][j][c];
            const f32x2 rs2 = (f32x2){1.f / sqrtf(wave_sum(s2.x) * (1.f / D) + EPS), 1.f / sqrtf(wave_sum(s2.y) * (1.f / D) + EPS)};
#pragma unroll
            for (int j = 0; j < 4; ++j)
#pragma unroll
                for (int c = 0; c < 4; ++c) xp[rp][j][c] = xp[rp][j][c] * rs2 * gv[j][c];
#if MOE_FP8
#pragma unroll
            for (int h = 0; h < 2; ++h) { GAS unsigned* o4 = (GAS unsigned*)((unsigned char*)XN + (size_t)(m0 + 2 * rp + h) * D) + lane;
#pragma unroll
                for (int j = 0; j < 4; ++j) o4[64 * j] = pg8::pk4_fp8(xp[rp][j][0][h] * SC_X, xp[rp][j][1][h] * SC_X, xp[rp][j][2][h] * SC_X, xp[rp][j][3][h] * SC_X); }
#else
#pragma unroll
            for (int h = 0; h < 2; ++h) { GAS v2u* o8 = (GAS v2u*)(XN + (size_t)(m0 + 2 * rp + h) * D) + lane;
#pragma unroll
                for (int j = 0; j < 4; ++j) { v2u w; w.x = pk2(xp[rp][j][0][h], xp[rp][j][1][h]); w.y = pk2(xp[rp][j][2][h], xp[rp][j][3][h]); o8[64 * j] = w; } }
#endif
        }
        f32x2 a2[2][16];
#pragma unroll
        for (int rp = 0; rp < 2; ++rp)
#pragma unroll
            for (int e = 0; e < 16; ++e) a2[rp][e] = (f32x2){0.f, 0.f};
#pragma unroll
        for (int e = 0; e < 16; ++e)
#pragma unroll
            for (int j = 0; j < 4; ++j) { const f32x4 wv = *(const LAS f32x4*)(wl + e * 1024 + 256 * j + 4 * lane);
#pragma unroll
                for (int rp = 0; rp < 2; ++rp) { a2[rp][e] += xp[rp][j][0] * wv.x; a2[rp][e] += xp[rp][j][1] * wv.y; a2[rp][e] += xp[rp][j][2] * wv.z; a2[rp][e] += xp[rp][j][3] * wv.w; }
                if (j == 3 && (e & 1)) asm volatile("" ::: "memory"); }
        float a[64];
#pragma unroll
        for (int r = 0; r < 4; ++r)
#pragma unroll
            for (int e = 0; e < 16; ++e) a[r * 16 + e] = a2[r >> 1][e][r & 1];
#pragma unroll
        for (int i = 0; i < 32; ++i) { const bool up = (lane & 32) != 0; const float keep = up ? a[i + 32] : a[i], send = up ? a[i] : a[i + 32]; a[i] = keep + __shfl_xor(send, 32); }
#pragma unroll
        for (int i = 0; i < 16; ++i) { const bool up = (lane & 16) != 0; const float keep = up ? a[i + 16] : a[i], send = up ? a[i] : a[i + 16]; a[i] = keep + __shfl_xor(send, 16); }
#pragma unroll
        for (int i = 0; i < 8; ++i) { const bool up = (lane & 8) != 0; const float keep = up ? a[i + 8] : a[i], send = up ? a[i] : a[i + 8]; a[i] = keep + __shfl_xor(send, 8); }
#pragma unroll
        for (int i = 0; i < 4; ++i) { const bool up = (lane & 4) != 0; const float keep = up ? a[i + 4] : a[i], send = up ? a[i] : a[i + 4]; a[i] = keep + __shfl_xor(send, 4); }
#pragma unroll
        for (int i = 0; i < 2; ++i) { const bool up = (lane & 2) != 0; const float keep = up ? a[i + 2] : a[i], send = up ? a[i] : a[i + 2]; a[i] = keep + __shfl_xor(send, 2); }
        { const bool up = (lane & 1) != 0; const float keep = up ? a[1] : a[0], send = up ? a[0] : a[1]; a[0] = keep + __shfl_xor(send, 1); }
        const float logit = a[0];
        float mx = logit;
#pragma unroll
        for (int o = 1; o < 16; o <<= 1) mx = fmaxf(mx, __shfl_xor(mx, o));
        const float p = expf(logit - mx); float sm = p;
#pragma unroll
        for (int o = 1; o < 16; o <<= 1) sm += __shfl_xor(sm, o);
        const int row = m0 + (lane >> 4), e = lane & 15, b = row >> 12, t = row & (SEQ - 1);
        AFF[((size_t)(b * 16 + e) << 12) + t] = p / sm;
    }
}

__device__ __forceinline__ void topk_phase(Frame& F, const float* AFF, int* IDX, float* GATE, int* INV) {
    LAS unsigned* hist = (LAS unsigned*)(F.lds + RING_OFF); LAS unsigned* sel = hist + 256; LAS unsigned* wtot = hist + 272;
    const int tid = F.tid, lane = F.lane, wave = F.wave;
    for (int job = blockIdx.x; job < BATCH * NE; job += F.G) {
        const int b = job >> 4, e = job & 15;
        const float* src = AFF + (size_t)job * SEQ + tid * 8;
        const f32x4 v0 = *(const GAS f32x4*)src, v1 = *(const GAS f32x4*)(src + 4);
        float av[8] = {v0.x, v0.y, v0.z, v0.w, v1.x, v1.y, v1.z, v1.w}; unsigned key[8];
#pragma unroll
        for (int i = 0; i < 8; ++i) key[i] = __float_as_uint(av[i]);
        unsigned prefix = 0u, mask = 0u, remaining = CAP;
#pragma unroll 1
        for (int pass = 0; pass < 4; ++pass) {
            const int shift = 24 - 8 * pass;
            if (tid < 256) hist[tid] = 0u;
            __syncthreads();
#pragma unroll
            for (int i = 0; i < 8; ++i) if ((key[i] & mask) == prefix) __hip_atomic_fetch_add(hist + ((key[i] >> shift) & 255u), 1u, __ATOMIC_RELAXED, __HIP_MEMORY_SCOPE_WORKGROUP);
            __syncthreads();
            if (wave == 0) {
                const unsigned h0 = hist[4 * lane], h1 = hist[4 * lane + 1], h2 = hist[4 * lane + 2], h3 = hist[4 * lane + 3];
                const unsigned c = h0 + h1 + h2 + h3;
                unsigned S = c;
#pragma unroll
                for (int o = 1; o < 64; o <<= 1) { const unsigned tt = __shfl_down(S, o); if (lane + o < 64) S += tt; }
                const unsigned Sn = S - c;
                if (Sn < remaining && remaining <= S) {
                    unsigned rem = remaining - Sn; int d;
                    if (h3 >= rem) d = 3; else { rem -= h3; if (h2 >= rem) d = 2; else { rem -= h2; if (h1 >= rem) d = 1; else { rem -= h1; d = 0; } } }
                    sel[0] = prefix | ((unsigned)(4 * lane + d) << shift); sel[1] = rem;
                }
            }
            __syncthreads();
            prefix = sel[0]; remaining = sel[1]; mask |= 0xFFu << shift;
        }
        const unsigned Tk = prefix;
        unsigned cg = 0u, ce = 0u;
#pragma unroll
        for (int i = 0; i < 8; ++i) { cg += key[i] > Tk ? 1u : 0u; ce += key[i] == Tk ? 1u : 0u; }
        const unsigned pk = cg | (ce << 16);
        unsigned inc = pk;
#pragma unroll
        for (int o = 1; o < 64; o <<= 1) { const unsigned tt = __shfl_up(inc, o); if (lane >= o) inc += tt; }
        if (lane == 63) wtot[wave] = inc;
        __syncthreads();
        unsigned base = 0u;
        for (int w = 0; w < wave; ++w) base += wtot[w];
        const unsigned excl = base + inc - pk;
        unsigned gt_before = excl & 0xFFFFu, eq_before = excl >> 16;
#pragma unroll
        for (int i = 0; i < 8; ++i) {
            const int t = tid * 8 + i; const unsigned k = key[i]; int slot = -1;
            if (k > Tk) { slot = (int)(gt_before + (eq_before < remaining ? eq_before : remaining)); ++gt_before; }
            else if (k == Tk) { if (eq_before < remaining) slot = (int)(gt_before + eq_before); ++eq_before; }
            INV[((size_t)(b * SEQ + t) << 4) + e] = slot;
            if (slot >= 0) { const int m = ((e * BATCH + b) << 9) + slot; IDX[m] = b * SEQ + t; GATE[m] = av[i]; }
        }
        __syncthreads();
    }
}

__device__ __forceinline__ void combine_phase(Frame& F, bf16* H, const unsigned char* Y, const int* INV, const float* gain, bf16* XN, float* OUT, bool fin, bool xn8 = false) {
    constexpr int RP = 8;
    const int gw = F.vcu * NWAVES + F.wave, NGW = F.G * NWAVES, lane = F.lane;
    typedef float f32x2 __attribute__((ext_vector_type(2)));
    f32x4 gv[2][2];
#pragma unroll
    for (int j = 0; j < 2; ++j) { gv[j][0] = *(const GAS f32x4*)(gain + 512 * j + 8 * lane); gv[j][1] = *(const GAS f32x4*)(gain + 512 * j + 8 * lane + 4); }
    for (int m0 = gw * RP; m0 < T; m0 += NGW * RP) {
        int inv[RP / 4];
#pragma unroll
        for (int q = 0; q < RP / 4; ++q) inv[q] = INV[((size_t)(m0 + 4 * q + (lane >> 4)) << 4) + (lane & 15)];
        f32x4 v[RP][2][2];
#pragma unroll
        for (int r = 0; r < RP; ++r)
#pragma unroll
            for (int j = 0; j < 2; ++j) { const v4u w = *(const GAS v4u*)(H + (size_t)(m0 + r) * D + 512 * j + 8 * lane);
                v[r][j][0] = (f32x4){bflo(w.x), bfhi(w.x), bflo(w.y), bfhi(w.y)}; v[r][j][1] = (f32x4){bflo(w.z), bfhi(w.z), bflo(w.w), bfhi(w.w)}; }
        unsigned mk[RP];
#pragma unroll
        for (int q = 0; q < RP / 4; ++q) { const unsigned long long vm = __ballot(inv[q] >= 0);
#pragma unroll
            for (int r = 0; r < 4; ++r) mk[4 * q + r] = (unsigned)(vm >> (16 * r)) & 0xFFFFu; }
        unsigned any = 0u;
#pragma unroll
        for (int r = 0; r < RP; ++r) any |= mk[r];
        while (any) {
            v2u y[RP][2]; bool has[RP];
#pragma unroll
            for (int r = 0; r < RP; ++r) {
                has[r] = mk[r] != 0u;
                if (has[r]) { const int e = __builtin_ctz(mk[r]); mk[r] &= mk[r] - 1u;
                    const int slot = __shfl(inv[r >> 2], (r & 3) * 16 + e); const int b = (m0 + r) >> 12;
                    const unsigned char* yp = Y + ((size_t)(((e * BATCH + b) << 9) + slot) << 10) + 8 * lane;
                    y[r][0] = *(const GAS v2u*)yp; y[r][1] = *(const GAS v2u*)(yp + 512); }
            }
            any = 0u;
#pragma unroll
            for (int r = 0; r < RP; ++r) { any |= mk[r]; if (has[r]) {
#pragma unroll
                for (int j = 0; j < 2; ++j) { const v2u w = y[r][j];
                    const f32x2 a = __builtin_amdgcn_cvt_pk_f32_fp8((int)w.x, false), b2 = __builtin_amdgcn_cvt_pk_f32_fp8((int)w.x, true), c = __builtin_amdgcn_cvt_pk_f32_fp8((int)w.y, false), d = __builtin_amdgcn_cvt_pk_f32_fp8((int)w.y, true);
                    v[r][j][0] += (f32x4){a.x, a.y, b2.x, b2.y} * (1.0f / SC_Y); v[r][j][1] += (f32x4){c.x, c.y, d.x, d.y} * (1.0f / SC_Y); }
            } }
        }
#pragma unroll
        for (int r = 0; r < RP; ++r) {
            float ss = 0.f;
#pragma unroll
            for (int j = 0; j < 2; ++j)
#pragma unroll
                for (int q = 0; q < 2; ++q) { const f32x4 x = v[r][j][q]; ss += (x.x * x.x + x.y * x.y) + (x.z * x.z + x.w * x.w); }
            const float rs = 1.f / sqrtf(wave_sum(ss) * (1.f / D) + EPS);
            if (!fin) {
#pragma unroll
                for (int j = 0; j < 2; ++j) { const f32x4 h0 = v[r][j][0], h1 = v[r][j][1];
                    v4u hw; hw.x = pk2(h0.x, h0.y); hw.y = pk2(h0.z, h0.w); hw.z = pk2(h1.x, h1.y); hw.w = pk2(h1.z, h1.w);
                    *(GAS v4u*)(H + (size_t)(m0 + r) * D + 512 * j + 8 * lane) = hw;
                    const f32x4 a0 = h0 * rs * gv[j][0], a1 = h1 * rs * gv[j][1];
                    if (xn8) { v2u w; const f32x4 b0_ = a0 * SC_X, b1_ = a1 * SC_X; w.x = pg8::pk4_fp8(b0_.x, b0_.y, b0_.z, b0_.w); w.y = pg8::pk4_fp8(b1_.x, b1_.y, b1_.z, b1_.w);
                        *(GAS v2u*)((unsigned char*)XN + (size_t)(m0 + r) * D + 512 * j + 8 * lane) = w; }
                    else { v4u w; w.x = pk2(a0.x, a0.y); w.y = pk2(a0.z, a0.w); w.z = pk2(a1.x, a1.y); w.w = pk2(a1.z, a1.w);
                        *(GAS v4u*)(XN + (size_t)(m0 + r) * D + 512 * j + 8 * lane) = w; } }
            } else {
#pragma unroll
                for (int j = 0; j < 2; ++j) { float* op = OUT + (size_t)(m0 + r) * D + 512 * j + 8 * lane; *(GAS f32x4*)op = v[r][j][0] * rs * gv[j][0]; *(GAS f32x4*)(op + 4) = v[r][j][1] * rs * gv[j][1]; }
            }
        }
    }
}

__device__ __forceinline__ void nan_rows_f32(Frame& F, float* out) {
    const int gw = F.vcu * NWAVES + F.wave, NGW = F.G * NWAVES; const float q = __builtin_nanf("");
    for (int m = gw; m < T; m += NGW) { GAS f32x4* o = (GAS f32x4*)(out + (size_t)m * D) + F.lane;
#pragma unroll
        for (int j = 0; j < 4; ++j) o[64 * j] = (f32x4){q, q, q, q}; }
}

#define MOE_BLOCK(layer, pb) do { \
    RUNPHASE((pb), router_phase(F, H, args.in[2] + layer * D, args.in[10] + (size_t)layer * D * NE, MOE_FP8 ? (bf16*)(ws + WS_XN8) : XN, AFF)); \
    SEAM(pb); \
    RUNPHASE((pb) + 1, topk_phase(F, AFF, IDX, GATE, INV)); \
    SEAM(pb + 1); \
    RUNPHASE((pb) + 2, { \
        pg8::Moe1Order S{F.G, F.vcu}; \
        LAS unsigned* gi = (LAS unsigned*)(F.lds + GIDX_OFF); \
        for (int i = 0; i < 16; ++i) { pg8::Unit u; if (!S.next(i, u)) break; \
            if (F.tid < 256) gi[i * 256 + F.tid] = (unsigned)IDX[u.pm * 256 + F.tid] * (unsigned)(D * ESZ); } \
        VM_WAIT(); LDS_WAIT(); __syncthreads(); \
        pg8::Gemm g{MOE_FP8 ? (const void*)(ws + WS_XN8) : (const void*)XN, ws + WS_WGU + (size_t)layer * NE * 4096 * 1024 * ESZ, D, gi, E8_X, E8_W, E8_WU}; \
        pg8::EpiSwiGLU<MOE_FP8 != 0> E{HMID, FF, SC_H}; \
        pg8::gemm_phase<pg8::EpiSwiGLU<MOE_FP8 != 0>, pg8::Moe1Order, true, MOE_FP8 != 0, KREP_MOE1>(F.lds + RING_OFF, g, S, E); \
    }); \
    SEAM(pb + 2); \
    RUNPHASE((pb) + 3, { \
        pg8::Moe2Order S{F.G, F.vcu}; \
        pg8::Gemm g{HMID, ws + WS_WD + (size_t)layer * NE * 1024 * 2048 * ESZ, FF, nullptr, E8_H, E8_W, E8_W}; \
        LAS float* gs = (LAS float*)(F.lds + GIDX_OFF);                       \
        for (int i = 0; i < 4; ++i) { pg8::Unit u; if (!S.next(i, u)) break; if (F.tid < 256) gs[i * 256 + F.tid] = GATE[u.pm * 256 + F.tid] * SC_Y; } \
        VM_WAIT(); LDS_WAIT(); __syncthreads(); \
        pg8::EpiScaleF8 E{Y, D, gs}; \
        pg8::gemm_phase<pg8::EpiScaleF8, pg8::Moe2Order, false, MOE_FP8 != 0>(F.lds + RING_OFF, g, S, E); \
    }); \
    SEAM(pb + 3); \
    RUNPHASE((pb) + 4, { \
        if (layer == 0) combine_phase(F, H, Y, INV, args.in[1] + D, ATTN_FP8 ? (bf16*)(ws + WS_XN8) : XN, nullptr, false, ATTN_FP8 != 0); \
        else { \
            const bool bad = __hip_atomic_load((gu32*)((unsigned*)(F.ctl + CW_BAR) + XB_TMO), RLX_AGENT) != 0u; \
            if (bad) nan_rows_f32(F, args.out); else combine_phase(F, H, Y, INV, args.in[14], nullptr, args.out, true); \
        } \
    }); \
    if (layer == 0) SEAM(pb + 4); \
    } while (0)
__global__ void __launch_bounds__(NWAVES * 64, 2) skel_fwd(Args args) {
    extern __shared__ __attribute__((aligned(1024))) unsigned char lds[];
    Frame F;
    F.lds = (LAS unsigned char*)lds;
    F.MISC = (volatile LAS unsigned*)(F.lds + MISC_OFF);
    F.tid = threadIdx.x; F.lane = F.tid & 63; F.wave = __builtin_amdgcn_readfirstlane(F.tid >> 6);
    F.G = gridDim.x; { const int bx = blockIdx.x; F.vcu = (F.G % 8 == 0) ? (bx % 8) * (F.G / 8) + bx / 8 : bx; }
    unsigned char* ws = args.ws;
    F.ctl = (gu32*)(ws + WS_CTL);
    for (int u = F.tid; u < (LDS_BYTES - LDSCTL_OFF) / 4; u += NWAVES * 64) ((LAS unsigned*)(F.lds + LDSCTL_OFF))[u] = 0u;
    __syncthreads();
    const int lo = args.ph_lo, hi = args.ph_hi;
    const bool use_bar = (hi - lo) > 1;
    XcdBarrier bar; bar.bar = (unsigned*)(F.ctl + CW_BAR); bar.x = 0; bar.st = nullptr;
    if (use_bar) bar = xcd_barrier_post((unsigned*)(F.ctl + CW_BAR), F.MISC + 8);
#ifndef PHASE_MASK
#define PHASE_MASK 0xFFFFF
#endif
#define EN(k) (((PHASE_MASK) >> (k)) & 1)
#define IN(k) (lo <= (k) && (k) < hi)
#ifndef REP_PHASE
#define REP_PHASE (-1)
#endif
#define RUNPHASE(k, ...) do { if (EN(k) && IN(k)) { __VA_ARGS__; if ((k) == REP_PHASE) { xcd_barrier(bar); __VA_ARGS__; } } } while (0)
#define SEAM(k) do { if (IN(k) && IN((k) + 1)) xcd_barrier(bar); } while (0)

    bf16* H = (bf16*)(ws + WS_HB);
    bf16* XN = (bf16*)(ws + WS_XN);
    bf16* BU = (bf16*)(ws + WS_BIG); bf16* Z = (bf16*)(ws + WS_BIG + 192 * MiB);
    bf16* QB_ = (bf16*)(ws + WS_BIG); bf16* KB_ = (bf16*)(ws + WS_BIG + 64 * MiB); bf16* VB_ = (bf16*)(ws + WS_BIG + 80 * MiB); bf16* OB_ = (bf16*)(ws + WS_BIG + 96 * MiB);
    bf16* HMID = (bf16*)(ws + WS_BIG); unsigned char* Y = (unsigned char*)(ws + WS_Y);
    float* AFF = (float*)(ws + WS_AFF); int* IDX = (int*)(ws + WS_IDX); float* GATE = (float*)(ws + WS_GATE); int* INV = (int*)(ws + WS_INV);
    const float* cosT = (const float*)(ws + WS_ROPE); const float* sinT = cosT + 1024;

    RUNPHASE(0, p0_prologue(F, args, ws));
    SEAM(0);
    RUNPHASE(1, {
        const int NC = (P1_CONV > 0 && (ATTN_SIDE || P1_ALL) && F.G > P1_CONV) ? F.G - P1_CONV : F.G;
        if ((int)blockIdx.x < NC) {
            pg8::Gemm g{XN, (const bf16*)(ws + WS_WIN), D, nullptr, 0, 0, 0}; pg8::StaticOrder S; S.init(T, 3 * D, NC, (int)blockIdx.x);
            pg8::EpiConvIn E{BU};
            pg8::gemm_phase<pg8::EpiConvIn, pg8::StaticOrder, false, false, KREP_P1>(F.lds + RING_OFF, g, S, E);
        }
        if (P1_ALL && NC < F.G) convert_dynamic(F, CW_CONV, 0, 2 * TR8_PER_LAYER / 8 - (F.G == 256 ? P10_PANELS : 0), args.in[11], args.in[12], args.in[13], (unsigned char*)(ws + WS_WGU), (unsigned char*)(ws + WS_WD));
    });
    SEAM(1);
    RUNPHASE(2, conv_phase(F, BU, args.in[4], Z));
    SEAM(2);
    RUNPHASE(3, {
        pg8::Gemm g{Z, (const bf16*)(ws + WS_WOUT), D, nullptr, 0, 0, 0}; pg8::StaticOrder S; S.init(T, D, F.G, (int)blockIdx.x);
        pg8::EpiBf16Res<true> E{args.in[0], H, D};
        pg8::gemm_phase<pg8::EpiBf16Res<true>, pg8::StaticOrder, false>(F.lds + RING_OFF, g, S, E);
    });
    SEAM(3);
    MOE_BLOCK(0, 4);
#if ATTN_FP8
    RUNPHASE(9, {
        pg8::Gemm g{ws + WS_XN8, ws + WS_WQKV, D, nullptr, E8_X, E8_W, E8_W}; pg8::StaticOrder S; S.init(T, NQKV, F.G, (int)blockIdx.x);
        LAS float* tb = (LAS float*)(F.lds + GIDX_OFF);
        for (int i = F.tid; i < 2048; i += NWAVES * 64) tb[i] = cosT[i];
        if (F.tid < 64) { tb[2048 + F.tid] = args.in[7][F.tid]; tb[2112 + F.tid] = args.in[8][F.tid]; }
        VM_WAIT(); LDS_WAIT(); __syncthreads();
        pg8::EpiQKV8 E{(unsigned char*)QB_, (unsigned char*)KB_, (unsigned char*)VB_, tb, attn8::SQ, attn8::SK, attn8::SV};
        pg8::gemm_phase<pg8::EpiQKV8, pg8::StaticOrder, false, true>(F.lds + RING_OFF, g, S, E);
    });
#else
    RUNPHASE(9, {
        pg8::Gemm g{XN, (const bf16*)(ws + WS_WQKV), D, nullptr, 0, 0, 0}; pg8::StaticOrder S; S.init(T, NQKV, F.G, (int)blockIdx.x);
        pg8::EpiQKV E{QB_, KB_, VB_, args.in[7], args.in[8], cosT, sinT, attn_body::C2};
        pg8::gemm_phase<pg8::EpiQKV, pg8::StaticOrder, false>(F.lds + RING_OFF, g, S, E);
    });
#endif
    SEAM(9);
    RUNPHASE(10, {
#if ATTN_FP8
        float att_sc;
        { float gq = fabsf(args.in[7][F.lane]), gk = fabsf(args.in[8][F.lane]);
          _Pragma("unroll") for (int o_ = 1; o_ < 64; o_ <<= 1) { gq = fmaxf(gq, __shfl_xor(gq, o_)); gk = fmaxf(gk, __shfl_xor(gk, o_)); }
          const float bnd = 1.13f * 64.f * attn_body::C2 * gq * gk; att_sc = exp2f(fmaxf(0.f, ceilf(bnd) - 15.f)); }
#endif
#if ATTN_FP8
        { attn8::i32x8 qcarry = (attn8::i32x8){0, 0, 0, 0, 0, 0, 0, 0};
#if ATTN_SIDE
          SideConv side; side.init(args.in[11], args.in[12], args.in[13], (unsigned char*)(ws + WS_WGU), (unsigned char*)(ws + WS_WD), F.lds + RING_OFF + attn8::LDS_SIDE + F.wave * 8192, F.vcu * NWAVES + F.wave, F.G * NWAVES);
#else
          SideNone side;
#endif
          const bool split10 = P1_ALL && P1_CONV > 0 && F.G == 256 && F.G > P1_CONV;
          const int NCG = split10 ? 32 - P10_HELP : 32, g10 = F.vcu >> 5, l10 = F.vcu & 31;
          if (F.G == 256) {
            if (l10 < NCG) for (int j = l10; j < 256; j += NCG) {
              const int b = g10, h = (j >> 6) * 4 + ((j >> 4) & 3), qb = j & 15;
              const int j2 = j + NCG; const bool hn = j2 < 256; const int h2 = (j2 >> 6) * 4 + ((j2 >> 4) & 3), qb2 = j2 & 15;
              attn8::attn_unit<8>(side, b, h, qb, j == l10, hn, b, h2, qb2, qcarry, (const unsigned char*)QB_, (const unsigned char*)KB_, (const unsigned char*)VB_, (attn8::bf16*)OB_, (char*)lds + RING_OFF, att_sc);
            }
          } else
          for (int i = 0; ; ++i) {
            const int L = i * F.G + F.vcu; if (L >= BATCH * 16 * 16) break;
            const int rnd = L >> 8, w = L & 255, b = w >> 5, l = w & 31, kvh = rnd >> 1, j = (rnd & 1) * 32 + l, h = kvh * 4 + (j >> 4), qb = j & 15;
            const int L2 = L + F.G; const bool hn = L2 < BATCH * 16 * 16;
            const int rnd2 = L2 >> 8, w2 = L2 & 255, b2 = w2 >> 5, l2 = w2 & 31, kvh2 = rnd2 >> 1, j2 = (rnd2 & 1) * 32 + l2, h2 = kvh2 * 4 + (j2 >> 4), qb2 = j2 & 15;
            attn8::attn_unit<8>(side, b, h, qb, i == 0, hn, b2, h2, qb2, qcarry, (const unsigned char*)QB_, (const unsigned char*)KB_, (const unsigned char*)VB_, (attn8::bf16*)OB_, (char*)lds + RING_OFF, att_sc);
          }
          if (split10) convert_dynamic(F, CW_CONV2, 2 * TR8_PER_LAYER / 8 - P10_PANELS, P10_PANELS, args.in[11], args.in[12], args.in[13], (unsigned char*)(ws + WS_WGU), (unsigned char*)(ws + WS_WD));
#if ATTN_SIDE
          side.flush(F.lane);
#endif
        }
#else
        for (int i = 0; ; ++i) {
            const int L = i * F.G + F.vcu; if (L >= BATCH * 16 * 16) break;
            const int rnd = L >> 8, w = L & 255, b = w >> 5, l = w & 31, kvh = rnd >> 1, j = (rnd & 1) * 32 + l, h = kvh * 4 + (j >> 4), qb = j & 15;
            attn_body::attn_unit<8>(b, h, qb, (const attn_body::bf16*)QB_, (const attn_body::bf16*)KB_, (const attn_body::bf16*)VB_, (attn_body::bf16*)OB_, (char*)lds + RING_OFF);
        }
#endif
    });
    SEAM(10);
#if ATTN_FP8
    RUNPHASE(11, {
        pg8::Gemm g{OB_, ws + WS_WO, D, nullptr, attn8::E8_O, E8_W, E8_W}; pg8::StaticOrder S; S.init(T, D, F.G, (int)blockIdx.x);
        pg8::EpiBf16Res<false> E{H, H, D};
        pg8::gemm_phase<pg8::EpiBf16Res<false>, pg8::StaticOrder, false, true>(F.lds + RING_OFF, g, S, E);
    });
#else
    RUNPHASE(11, {
        pg8::Gemm g{OB_, (const bf16*)(ws + WS_WO), D, nullptr, 0, 0, 0}; pg8::StaticOrder S; S.init(T, D, F.G, (int)blockIdx.x);
        pg8::EpiBf16Res<false> E{H, H, D};
        pg8::gemm_phase<pg8::EpiBf16Res<false>, pg8::StaticOrder, false>(F.lds + RING_OFF, g, S, E);
    });
#endif
    SEAM(11);
    MOE_BLOCK(1, 12);
#undef IN
#undef SEAM
}

extern "C" void kernel_launch(void* const* d_in, const int* in_sizes, int n_in, void* d_out, int out_size, void* d_ws, size_t ws_size, hipStream_t stream) {
    static int grid = 0;
    if (grid == 0) {
        if (n_in != 15 || in_sizes[0] != T * D || out_size != T * D || ws_size < WS_END) { fprintf(stderr, "kernel_launch: unexpected shapes (n_in %d, in0 %d, out %d, ws %zu); nothing launched\n", n_in, n_in > 0 ? in_sizes[0] : -1, out_size, ws_size); grid = -1; return; }
        int dev = 0, cus = 0, per_cu = 0;
        if (hipGetDevice(&dev) != hipSuccess || hipDeviceGetAttribute(&cus, hipDeviceAttributeMultiprocessorCount, dev) != hipSuccess) { grid = -1; return; }
        if (hipFuncSetAttribute((const void*)skel_fwd, hipFuncAttributeMaxDynamicSharedMemorySize, LDS_BYTES) != hipSuccess) { fprintf(stderr, "kernel_launch: hipFuncSetAttribute failed\n"); grid = -1; return; }
        if (hipOccupancyMaxActiveBlocksPerMultiprocessor(&per_cu, (const void*)skel_fwd, NWAVES * 64, LDS_BYTES) != hipSuccess || per_cu < 1)
            fprintf(stderr, "kernel_launch: note: occupancy query reports %d workgroups per CU\n", per_cu);
        (void)hipGetLastError();
        grid = cus;
    }
    if (grid < 0) return;
    if (hipMemsetAsync((char*)d_ws + WS_CTL, 0, CTL_ZERO_BYTES, stream) != hipSuccess) { fprintf(stderr, "kernel_launch: hipMemsetAsync failed\n"); return; }
    Args a{};
    for (int i = 0; i < 15; ++i) a.in[i] = (const float*)d_in[i];
    a.out = (float*)d_out; a.ws = (unsigned char*)d_ws;
    if (N_LAUNCHES == 1) {
        a.ph_lo = 0; a.ph_hi = N_PHASES;
        hipLaunchKernelGGL(skel_fwd, dim3(grid), dim3(NWAVES * 64), LDS_BYTES, stream, a);
    } else {
        for (int p = 0; p < N_PHASES; ++p) { a.ph_lo = p; a.ph_hi = p + 1; hipLaunchKernelGGL(skel_fwd, dim3(grid), dim3(NWAVES * 64), LDS_BYTES, stream, a); }
    }
    const hipError_t le = hipPeekAtLastError();
    if (le != hipSuccess) fprintf(stderr, "kernel_launch: launch failed: %s\n", hipGetErrorName(le));
}
```

```cpp
#include <hip/hip_runtime.h>
#include <hip/hip_bf16.h>
#include <cstdio>
#include <cstdint>
#include <cmath>

#ifndef MOE_FP8
#define MOE_FP8 1
#endif
#ifndef ATTN_FP8
#ifndef P0_REP
#define P0_REP 0
#endif
#define NORM_FOLD 1
#ifndef P1_CONV
#define P1_CONV 64
#endif
#define P10_PANELS 2432
#define P10_HELP 3
#define P1_ALL 1
#define P1_SPLIT 24576
#define ATTN_SIDE 0
#define ATTN_FP8 1
#endif
#ifndef KREP_MOE1
#define KREP_MOE1 1
#endif
#ifndef KREP_P1
#define KREP_P1 1
#endif
#ifndef MK_N_LAUNCHES
#define MK_N_LAUNCHES 1
#endif

namespace pg8 {
#define PG8_LAS __attribute__((address_space(3)))
typedef unsigned short bf16_t;
typedef short bf16x8 __attribute__((ext_vector_type(8)));
typedef float f32x4 __attribute__((ext_vector_type(4)));
typedef unsigned u32x4 __attribute__((ext_vector_type(4)));
typedef int i32x4 __attribute__((ext_vector_type(4)));
typedef int i32x8 __attribute__((ext_vector_type(8)));
constexpr int BM = 256, BK = 64, HALF = 128, HTB = HALF * BK * 2  , STAGE_BYTES = 8 * HTB, NXCD = 8, WGM = 8;

__host__ __device__ __forceinline__ int lds_byte(int r, int c) { const int st = (r >> 4) * 2 + (c >> 5), rr = r & 15, cc = c & 31, ob = rr * 64 + cc * 2; return st * 1024 + (ob ^ (((ob >> 9) & 1) << 5)); }
__host__ __device__ __forceinline__ void stage_rc(int b, int& R, int& C) { const int st = b / 1024, sb = b % 1024, swz = sb ^ (((sb >> 9) & 1) << 5); R = (st >> 1) * 16 + swz / 64; C = (st & 1) * 32 + (swz % 64) / 2; }
__host__ __device__ __forceinline__ int perm32(int rho) { const int n = rho >> 4, i = rho & 15; return 8 * (i >> 2) + 4 * n + (i & 3); }

struct Unit { int pm, pn, bt, ui; };
struct Gemm { const void* A; const void* Bt; int K; const PG8_LAS unsigned* gidx; int sa, sb, sb1; };

struct StaticOrder {
    int nM, nN, nwg, G, c;
    __host__ __device__ __forceinline__ void init(int M, int N, int G_, int c_) { nM = M / BM; nN = N / BM; nwg = nM * nN; G = G_; c = c_; }
    __host__ __device__ __forceinline__ bool next(int i, Unit& u) const {
        const long L = (long)i * G + c; if (L >= nwg) return false;
        int wgid = (int)L; { const int q = nwg / NXCD, r = nwg % NXCD, xcd = wgid % NXCD, off = wgid / NXCD; wgid = (xcd < r ? xcd * (q + 1) : r * (q + 1) + (xcd - r) * q) + off; }
        const int nig = WGM * nN, gid = wgid / nig, fm = gid * WGM, gsz = (nM - fm) < WGM ? (nM - fm) : WGM;
        u.pm = fm + ((wgid % nig) % gsz); u.pn = (wgid % nig) / gsz; u.bt = u.pn; u.ui = i; return true;
    }
};
struct Moe1Order {
    int G, c;
    __device__ __forceinline__ bool next(int i, Unit& u) const {
        const int L = i * G + c; if (L >= 4096) return false;
        const int e = L >> 8, w = L & 255, x = w >> 5, l = w & 31;
        const int rt = 4 * (x >> 1) + (l >> 3), pn = 8 * (x & 1) + (l & 7);
        u.pm = e * 16 + rt; u.pn = pn; u.bt = e * 16 + pn; u.ui = i; return true;
    }
};
struct Moe2Order {
    int G, c;
    __device__ __forceinline__ bool next(int i, Unit& u) const {
        const int L = i * G + c; if (L >= 1024) return false;
        const int r4 = L >> 8, w = L & 255, x = w >> 5, l = w & 31;
        const int e = 4 * r4 + (x >> 1), rt = 8 * (x & 1) + (l >> 2), pn = l & 3;
        u.pm = e * 16 + rt; u.pn = pn; u.bt = e * 4 + pn; u.ui = i; return true;
    }
};

__device__ __forceinline__ unsigned cvt_pk_bf16(float lo, float hi) { unsigned r; asm volatile("v_cvt_pk_bf16_f32 %0, %1, %2" : "=v"(r) : "v"(lo), "v"(hi)); return r; }
__device__ __forceinline__ u32x4 pack8(const f32x4 a, const f32x4 b) { u32x4 w; w.x = cvt_pk_bf16(a[0], a[1]); w.y = cvt_pk_bf16(a[2], a[3]); w.z = cvt_pk_bf16(b[0], b[1]); w.w = cvt_pk_bf16(b[2], b[3]); return w; }

__device__ __forceinline__ u32x4 dpp_ror8(u32x4 v) { u32x4 r; r.x = (unsigned)__builtin_amdgcn_mov_dpp((int)v.x, 0x128, 0xF, 0xF, true); r.y = (unsigned)__builtin_amdgcn_mov_dpp((int)v.y, 0x128, 0xF, 0xF, true);
    r.z = (unsigned)__builtin_amdgcn_mov_dpp((int)v.z, 0x128, 0xF, 0xF, true); r.w = (unsigned)__builtin_amdgcn_mov_dpp((int)v.w, 0x128, 0xF, 0xF, true); return r; }
struct EpiBf16 {
    static constexpr bool PERM = true, WIDE = true;
    bf16_t* O; int ldc;
    __device__ __forceinline__ void operator()(const f32x4 (&acc)[2][2][4][2], const Unit& u, int wr, int wc, int fr, int fq) const {
        const bool hi8 = (fr & 8) != 0;
        const int row0 = u.pm * BM + wr * 64 + (fr & 7), col0 = u.pn * BM + wc * 64 + (hi8 ? 32 : 0) + 8 * fq;
#pragma unroll
        for (int ai = 0; ai < 2; ++ai)
#pragma unroll
            for (int m = 0; m < 4; ++m) { bf16_t* rowp = O + (size_t)(row0 + ai * HALF + m * 16) * ldc + col0;
                const u32x4 p0 = pack8(acc[ai][0][m][0], acc[ai][0][m][1]), p1 = pack8(acc[ai][1][m][0], acc[ai][1][m][1]);
                const u32x4 snd = hi8 ? p0 : p1, rcv = dpp_ror8(snd);
                *(u32x4*)rowp = hi8 ? rcv : p0;
                *(u32x4*)(rowp + (size_t)8 * ldc) = hi8 ? p1 : rcv; }
    }
};
struct EpiF32Res {
    static constexpr bool PERM = false, WIDE = false;
    const float* base; float* out; int ldc;
    __device__ __forceinline__ void operator()(const f32x4 (&acc)[2][2][4][2], const Unit& u, int wr, int wc, int fr, int fq) const {
        const int row0 = u.pm * BM + wr * 64 + fr, col0 = u.pn * BM + wc * 32 + 4 * fq;
#pragma unroll
        for (int ai = 0; ai < 2; ++ai)
#pragma unroll
            for (int m = 0; m < 4; ++m) { const size_t off = (size_t)(row0 + ai * HALF + m * 16) * ldc + col0;
                f32x4 bs[2][2];
#pragma unroll
                for (int bj = 0; bj < 2; ++bj)
#pragma unroll
                    for (int n = 0; n < 2; ++n) bs[bj][n] = *(const f32x4*)(base + off + bj * HALF + n * 16);
#pragma unroll
                for (int bj = 0; bj < 2; ++bj)
#pragma unroll
                    for (int n = 0; n < 2; ++n) *(f32x4*)(out + off + bj * HALF + n * 16) = bs[bj][n] + acc[ai][bj][m][n];
                if (m & 1) asm volatile("" ::: "memory"); }
    }
};
template <bool BASE_F32> struct EpiBf16Res {
    static constexpr bool PERM = true, WIDE = false;
    const void* base; bf16_t* out; int ldc;
    __device__ __forceinline__ void operator()(const f32x4 (&acc)[2][2][4][2], const Unit& u, int wr, int wc, int fr, int fq) const {
        const int row0 = u.pm * BM + wr * 64 + fr, col0 = u.pn * BM + wc * 32 + 8 * fq;
#pragma unroll
        for (int ai = 0; ai < 2; ++ai)
#pragma unroll
            for (int m = 0; m < 4; ++m) { const size_t off = (size_t)(row0 + ai * HALF + m * 16) * ldc + col0;
                f32x4 b0[2], b1[2];
#pragma unroll
                for (int bj = 0; bj < 2; ++bj) {
                    if constexpr (BASE_F32) { const float* bp = (const float*)base + off + bj * HALF; b0[bj] = *(const f32x4*)bp; b1[bj] = *(const f32x4*)(bp + 4); }
                    else { const u32x4 w = *(const u32x4*)((const bf16_t*)base + off + bj * HALF);
                        b0[bj] = (f32x4){__uint_as_float(w.x << 16), __uint_as_float(w.x & 0xffff0000u), __uint_as_float(w.y << 16), __uint_as_float(w.y & 0xffff0000u)};
                        b1[bj] = (f32x4){__uint_as_float(w.z << 16), __uint_as_float(w.z & 0xffff0000u), __uint_as_float(w.w << 16), __uint_as_float(w.w & 0xffff0000u)}; } }
#pragma unroll
                for (int bj = 0; bj < 2; ++bj) *(u32x4*)(out + off + bj * HALF) = pack8(b0[bj] + acc[ai][bj][m][0], b1[bj] + acc[ai][bj][m][1]);
                if (m & 1) asm volatile("" ::: "memory"); }
    }
};
struct EpiConvIn {
    static constexpr bool PERM = true, WIDE = false;
    bf16_t* O; const PG8_LAS float* rsc;
    __device__ __forceinline__ void operator()(const f32x4 (&acc)[2][2][4][2], const Unit& u, int wr, int wc, int fr, int fq) const {
        const int row0 = u.pm * BM + wr * 64 + fr;
        float sc[2][4];
#pragma unroll
        for (int ai = 0; ai < 2; ++ai)
#pragma unroll
            for (int m = 0; m < 4; ++m) sc[ai][m] = rsc ? rsc[u.ui * 256 + wr * 64 + fr + ai * HALF + m * 16] : 1.f;
        if (u.pn < 4) {
            const int col0 = u.pn * BM + wc * 32 + 8 * fq;
#pragma unroll
            for (int ai = 0; ai < 2; ++ai)
#pragma unroll
                for (int m = 0; m < 4; ++m) { bf16_t* rowp = O + (size_t)(row0 + ai * HALF + m * 16) * 2048 + col0; const float s_ = sc[ai][m];
#pragma unroll
                    for (int bj = 0; bj < 2; ++bj) *(u32x4*)(rowp + bj * HALF) = pack8(acc[ai][bj][m][0] * s_, acc[ai][bj][m][1] * s_); }
        } else {
            const int col0 = 1024 + (u.pn - 4) * HALF + wc * 32 + 8 * fq;
#pragma unroll
            for (int ai = 0; ai < 2; ++ai)
#pragma unroll
                for (int m = 0; m < 4; ++m) { const float s2_ = sc[ai][m] * sc[ai][m];
                    *(u32x4*)(O + (size_t)(row0 + ai * HALF + m * 16) * 2048 + col0) = pack8(acc[ai][0][m][0] * acc[ai][1][m][0] * s2_, acc[ai][0][m][1] * acc[ai][1][m][1] * s2_); }
        }
    }
};
__device__ __forceinline__ float silu_f(float x) { return x * __builtin_amdgcn_rcpf(1.0f + __builtin_amdgcn_exp2f(-1.4426950408889634f * x)); }
__device__ __forceinline__ float clamp448(float x) { return __builtin_fminf(__builtin_fmaxf(x, -448.f), 448.f); }
__device__ __forceinline__ unsigned pk4_fp8(float a, float b, float c, float d) { int w = 0; w = __builtin_amdgcn_cvt_pk_fp8_f32(clamp448(a), clamp448(b), w, false); w = __builtin_amdgcn_cvt_pk_fp8_f32(clamp448(c), clamp448(d), w, true); return (unsigned)w; }
template <bool F8> struct EpiSwiGLU {
    static constexpr bool PERM = true, WIDE = false;
    void* O; int ldc; float oscale;
    __device__ __forceinline__ void operator()(const f32x4 (&acc)[2][2][4][2], const Unit& u, int wr, int wc, int fr, int fq) const {
        const int row0 = u.pm * BM + wr * 64 + fr, col0 = u.pn * HALF + wc * 32 + 8 * fq;
#pragma unroll
        for (int ai = 0; ai < 2; ++ai)
#pragma unroll
            for (int m = 0; m < 4; ++m) {
                f32x4 h0, h1;
#pragma unroll
                for (int j = 0; j < 4; ++j) {
                    if constexpr (F8) {
                        h0[j] = acc[ai][0][m][0][j] * acc[ai][1][m][0][j] * __builtin_amdgcn_rcpf(1.0f + __builtin_amdgcn_exp2f(acc[ai][0][m][0][j]));
                        h1[j] = acc[ai][0][m][1][j] * acc[ai][1][m][1][j] * __builtin_amdgcn_rcpf(1.0f + __builtin_amdgcn_exp2f(acc[ai][0][m][1][j])); }
                    else { h0[j] = silu_f(acc[ai][0][m][0][j]) * acc[ai][1][m][0][j]; h1[j] = silu_f(acc[ai][0][m][1][j]) * acc[ai][1][m][1][j]; } }
                const size_t off = (size_t)(row0 + ai * HALF + m * 16) * ldc + col0;
                if constexpr (F8) { typedef unsigned u32x2 __attribute__((ext_vector_type(2)));
                    u32x2 w; w.x = pk4_fp8(h0[0], h0[1], h0[2], h0[3]); w.y = pk4_fp8(h1[0], h1[1], h1[2], h1[3]); __builtin_nontemporal_store(w, (u32x2*)((unsigned char*)O + off)); }
                else *(u32x4*)((bf16_t*)O + off) = pack8(h0, h1); }
    }
};
struct EpiScaleBf16 {
    static constexpr bool PERM = true, WIDE = false;
    bf16_t* O; int ldc; const float* rowscale;
    __device__ __forceinline__ void operator()(const f32x4 (&acc)[2][2][4][2], const Unit& u, int wr, int wc, int fr, int fq) const {
        const int row0 = u.pm * BM + wr * 64 + fr, col0 = u.pn * BM + wc * 32 + 8 * fq;
        float sc[2][4];
#pragma unroll
        for (int ai = 0; ai < 2; ++ai)
#pragma unroll
            for (int m = 0; m < 4; ++m) sc[ai][m] = rowscale[row0 + ai * HALF + m * 16];
#pragma unroll
        for (int ai = 0; ai < 2; ++ai)
#pragma unroll
            for (int m = 0; m < 4; ++m) { bf16_t* rowp = O + (size_t)(row0 + ai * HALF + m * 16) * ldc + col0; const float s = sc[ai][m];
#pragma unroll
                for (int bj = 0; bj < 2; ++bj) *(u32x4*)(rowp + bj * HALF) = pack8(acc[ai][bj][m][0] * s, acc[ai][bj][m][1] * s); }
    }
};
struct EpiScaleF8 {
    static constexpr bool PERM = true, WIDE = false;
    unsigned char* O; int ldc; const PG8_LAS float* rsc;
    __device__ __forceinline__ void operator()(const f32x4 (&acc)[2][2][4][2], const Unit& u, int wr, int wc, int fr, int fq) const {
        typedef unsigned u32x2 __attribute__((ext_vector_type(2)));
        const int row0 = u.pm * BM + wr * 64 + fr, col0 = u.pn * BM + wc * 32 + 8 * fq;
        float sc[2][4];
#pragma unroll
        for (int ai = 0; ai < 2; ++ai)
#pragma unroll
            for (int m = 0; m < 4; ++m) sc[ai][m] = rsc[u.ui * 256 + wr * 64 + fr + ai * HALF + m * 16];
#pragma unroll
        for (int ai = 0; ai < 2; ++ai)
#pragma unroll
            for (int m = 0; m < 4; ++m) { unsigned char* rowp = O + (size_t)(row0 + ai * HALF + m * 16) * ldc + col0; const float s_ = sc[ai][m];
#pragma unroll
                for (int bj = 0; bj < 2; ++bj) { const f32x4 a = acc[ai][bj][m][0] * s_, b = acc[ai][bj][m][1] * s_; u32x2 w; w.x = pk4_fp8(a[0], a[1], a[2], a[3]); w.y = pk4_fp8(b[0], b[1], b[2], b[3]); *(u32x2*)(rowp + bj * HALF) = w; } }
    }
};
struct EpiQKV {
    static constexpr bool PERM = true, WIDE = false;
    bf16_t *Q, *Kb, *Vb; const float *gq, *gk, *cosT, *sinT; float qscale;
    __device__ __forceinline__ void operator()(const f32x4 (&acc)[2][2][4][2], const Unit& u, int wr, int wc, int fr, int fq) const {
        const int row0 = u.pm * BM + wr * 64 + fr;
        if (u.pn < 5) {
            const bool isq = u.pn < 4;
            const float* g = isq ? gq : gk;
            bf16_t* base = isq ? Q + (u.pn * 4 + wc) * 64 : Kb + wc * 64; const int ldc = isq ? 1024 : 256;
            const float osc = isq ? qscale : 1.0f;
            f32x4 gn[2][2];
#pragma unroll
            for (int bj = 0; bj < 2; ++bj)
#pragma unroll
                for (int n = 0; n < 2; ++n) gn[bj][n] = *(const f32x4*)(g + 32 * bj + 16 * n + 4 * fq);
#pragma unroll
            for (int ai = 0; ai < 2; ++ai)
#pragma unroll
                for (int m = 0; m < 4; ++m) {
                    const int r = row0 + ai * HALF + m * 16, t = r & 4095, pr = t >> 6, pc = t & 63;
                    float ss = 0.f;
#pragma unroll
                    for (int bj = 0; bj < 2; ++bj)
#pragma unroll
                        for (int n = 0; n < 2; ++n) { const f32x4 x = acc[ai][bj][m][n]; ss += (x[0] * x[0] + x[1] * x[1]) + (x[2] * x[2] + x[3] * x[3]); }
                    ss += __shfl_xor(ss, 16); ss += __shfl_xor(ss, 32);
                    const float rs = osc / sqrtf(ss * (1.0f / 64.0f) + 1e-6f);
#pragma unroll
                    for (int bj = 0; bj < 2; ++bj) {
                        const int pos = bj ? pc : pr;
                        const f32x4 c4 = *(const f32x4*)(cosT + pos * 16 + 4 * fq), s4 = *(const f32x4*)(sinT + pos * 16 + 4 * fq);
                        const f32x4 x1 = acc[ai][bj][m][0] * rs * gn[bj][0], x2 = acc[ai][bj][m][1] * rs * gn[bj][1];
                        const f32x4 o1 = x1 * c4 - x2 * s4, o2 = x2 * c4 + x1 * s4;
                        *(u32x4*)(base + (size_t)r * ldc + 32 * bj + 8 * fq) = pack8(o1, o2);
                    }
                    asm volatile("" ::: "memory");
                }
        } else {
#pragma unroll
            for (int ai = 0; ai < 2; ++ai)
#pragma unroll
                for (int m = 0; m < 4; ++m) { const int r = row0 + ai * HALF + m * 16;
#pragma unroll
                    for (int bj = 0; bj < 2; ++bj) *(u32x4*)(Vb + (size_t)r * 256 + wc * 64 + 32 * bj + 8 * fq) = pack8(acc[ai][bj][m][0], acc[ai][bj][m][1]); }
        }
    }
};

struct EpiQKV8 {
    static constexpr bool PERM = true, WIDE = false;
    unsigned char *Q8, *K8, *V8p; const PG8_LAS float* tab; float qscale, kscale, vscale;
    __device__ __forceinline__ void operator()(const f32x4 (&acc)[2][2][4][2], const Unit& u, int wr, int wc, int fr, int fq) const {
        typedef unsigned u32x2 __attribute__((ext_vector_type(2)));
        const int row0 = u.pm * BM + wr * 64 + fr;
        if (u.pn < 5) {
            const bool isq = u.pn < 4;
            const PG8_LAS float* g = tab + 2048 + (isq ? 0 : 64);
            unsigned char* base = isq ? Q8 + (u.pn * 4 + wc) * 64 : K8 + wc * 64; const int ldc = isq ? 1024 : 256;
            const float osc = isq ? qscale : kscale;
            f32x4 gn[2][2];
#pragma unroll
            for (int bj = 0; bj < 2; ++bj)
#pragma unroll
                for (int n = 0; n < 2; ++n) gn[bj][n] = *(const PG8_LAS f32x4*)(g + 32 * bj + 16 * n + 4 * fq);
#pragma unroll
            for (int ai = 0; ai < 2; ++ai)
#pragma unroll
                for (int m = 0; m < 4; ++m) {
                    const int r = row0 + ai * HALF + m * 16, t = r & 4095, pr = t >> 6, pc = t & 63;
                    float ss = 0.f;
#pragma unroll
                    for (int bj = 0; bj < 2; ++bj)
#pragma unroll
                        for (int n = 0; n < 2; ++n) { const f32x4 x = acc[ai][bj][m][n]; ss += (x[0] * x[0] + x[1] * x[1]) + (x[2] * x[2] + x[3] * x[3]); }
                    ss += __shfl_xor(ss, 16); ss += __shfl_xor(ss, 32);
                    const float rs = osc / sqrtf(ss * (1.0f / 64.0f) + 1e-6f);
#pragma unroll
                    for (int bj = 0; bj < 2; ++bj) {
                        const int pos = bj ? pc : pr;
                        const f32x4 c4 = *(const PG8_LAS f32x4*)(tab + pos * 16 + 4 * fq), s4 = *(const PG8_LAS f32x4*)(tab + 1024 + pos * 16 + 4 * fq);
                        const f32x4 x1 = acc[ai][bj][m][0] * rs * gn[bj][0], x2 = acc[ai][bj][m][1] * rs * gn[bj][1];
                        const f32x4 o1 = x1 * c4 - x2 * s4, o2 = x2 * c4 + x1 * s4;
                        u32x2 w; w.x = pk4_fp8(o1[0], o1[1], o1[2], o1[3]); w.y = pk4_fp8(o2[0], o2[1], o2[2], o2[3]);
                        *(u32x2*)(base + (size_t)r * ldc + 32 * bj + 8 * fq) = w;
                    }
                    if (m & 1) asm volatile("" ::: "memory");
                }
        } else {
            const bool even = (fr & 1) == 0;
#pragma unroll
            for (int ai = 0; ai < 2; ++ai)
#pragma unroll
                for (int m = 0; m < 4; ++m) { const int r = row0 + ai * HALF + m * 16;
#pragma unroll
                    for (int bj = 0; bj < 2; ++bj) { const f32x4 a = acc[ai][bj][m][0] * vscale, b = acc[ai][bj][m][1] * vscale;
                        const unsigned ox = pk4_fp8(a[0], a[1], a[2], a[3]), oy = pk4_fp8(b[0], b[1], b[2], b[3]);
                        const unsigned rx = (unsigned)__builtin_amdgcn_mov_dpp((int)ox, 0xB1, 0xF, 0xF, true), ry = (unsigned)__builtin_amdgcn_mov_dpp((int)oy, 0xB1, 0xF, 0xF, true);
                        const unsigned A = even ? ox : ry, B = even ? rx : oy;
                        u32x2 w; w.x = __builtin_amdgcn_perm(B, A, 0x05010400u); w.y = __builtin_amdgcn_perm(B, A, 0x07030602u);
                        *(u32x2*)(V8p + ((size_t)(r >> 1) * 256 + wc * 64 + 32 * bj + 8 * fq + 4 * (fr & 1)) * 2) = w; } }
        }
    }
};

template <class Epi, class Sched, bool GATHER, bool FP8 = false, int KREP = 1>
__device__ __forceinline__ void gemm_phase(PG8_LAS unsigned char* lds, const Gemm g, const Sched& S, const Epi& E) {
    const int tid = threadIdx.x, wid = __builtin_amdgcn_readfirstlane(tid >> 6), lane = tid & 63, wr = wid >> 2, wc = wid & 3, fr = lane & 15, fq = lane >> 4;
    const int KB = FP8 ? g.K : g.K * 2, nt = KB / 128;
    unsigned voffA[2], voffB[2]; int RA[2], CA[2];
#pragma unroll
    for (int i = 0; i < 2; ++i) { int R, C;
        if constexpr (FP8) { const int P = tid + 512 * i, hb = P & 1, q = P >> 1, fr_ = q & 15, fq_ = (q >> 4) & 3, mp = q >> 6; R = 16 * mp + fr_; C = 32 * fq_ + 16 * (hb ^ ((fr_ >> 3) & 1)); }
        else { stage_rc(tid * 16 + i * 8192, R, C); C *= 2; }
        const int Rb = Epi::WIDE ? (64 * (R >> 5) + perm32(R & 31)) : (Epi::PERM ? ((R & ~31) + perm32(R & 31)) : R);
        voffA[i] = (unsigned)(R * KB + C); voffB[i] = (unsigned)(Rb * KB + C); RA[i] = R; CA[i] = C; }
    const size_t kstep = (size_t)128;
    const size_t hstep = (size_t)HALF * KB, hstepB = Epi::WIDE ? (size_t)32 * KB : hstep;
    const size_t tstep = 2 * hstep;
    const unsigned ldsw = (unsigned)wid * 1024u;
    const int aoff = FP8 ? (wr * 8192 + lane * 32 + 16 * ((lane >> 3) & 1)) : lds_byte(wr * 64 + fr, fq * 8), boff = FP8 ? (wc * 4096 + lane * 32 + 16 * ((lane >> 3) & 1)) : lds_byte(wc * 32 + fr, fq * 8);
    const int aoff1 = aoff ^ 16, boff1 = boff ^ 16;
    const int sa = g.sa, sb = g.sb, sb1 = g.sb1;
#define PG8_SA(b, h) (((b) * 2 + (h)) * HTB)
#define PG8_SB(b, h) ((4 + (b) * 2 + (h)) * HTB)
#define PG8_STAGE(bufoff, gbase, voff) do { _Pragma("unroll") for (int _i = 0; _i < 2; ++_i) \
        __builtin_amdgcn_global_load_lds((const unsigned*)((const char*)(gbase) + (voff)[_i]), (PG8_LAS unsigned*)(lds + (bufoff) + ldsw + _i * 8192), 16, 0, 0); } while (0)
#define PG8_STAGE_A(bufoff, p, h, usenext) do { if constexpr (GATHER) { unsigned _o[2]; _o[0] = (usenext) ? on[h][0] : oc[h][0]; _o[1] = (usenext) ? on[h][1] : oc[h][1]; PG8_STAGE(bufoff, p, _o); } \
        else { PG8_STAGE(bufoff, (p) + (h) * hstep, voffA); } } while (0)
#define PG8_LD8(p0, p1) __builtin_shufflevector(*(const PG8_LAS i32x4*)(p0), *(const PG8_LAS i32x4*)(p1), 0, 1, 2, 3, 4, 5, 6, 7)
#define PG8_LDA(dst, b, h) do { _Pragma("unroll") for (int m = 0; m < 4; ++m) { if constexpr (FP8) { dst##8[m] = PG8_LD8(lds + PG8_SA(b, h) + aoff + m * 2048, lds + PG8_SA(b, h) + aoff1 + m * 2048); } \
        else { _Pragma("unroll") for (int k = 0; k < 2; ++k) dst[m][k] = *(const PG8_LAS bf16x8*)(lds + PG8_SA(b, h) + aoff + m * 2048 + k * 1024); } } } while (0)
#define PG8_LDB(dst, b, h) do { _Pragma("unroll") for (int n = 0; n < 2; ++n) { if constexpr (FP8) { dst##8[n] = PG8_LD8(lds + PG8_SB(b, h) + boff + n * 2048, lds + PG8_SB(b, h) + boff1 + n * 2048); } \
        else { _Pragma("unroll") for (int k = 0; k < 2; ++k) dst[n][k] = *(const PG8_LAS bf16x8*)(lds + PG8_SB(b, h) + boff + n * 2048 + k * 1024); } } } while (0)
#define PG8_MMA(ai, bj, At, Bt, Z) do { __builtin_amdgcn_s_setprio(1); \
        if (FP8 && (Z)) { _Pragma("unroll") for (int m = 0; m < 4; ++m) _Pragma("unroll") for (int n = 0; n < 2; ++n) {              \
            if constexpr (FP8) asm volatile("v_mfma_scale_f32_16x16x128_f8f6f4 %0, %1, %2, 0, %3, %4 op_sel_hi:[0,0,0]" : "=v"(acc[ai][bj][m][n]) : "v"(Bt##8[n]), "v"(At##8[m]), "v"((bj) ? sb1 : sb), "v"(sa)); \
            else { acc[ai][bj][m][n] = __builtin_amdgcn_mfma_f32_16x16x32_bf16(Bt[n][0], At[m][0], (f32x4){0.f, 0.f, 0.f, 0.f}, 0, 0, 0); acc[ai][bj][m][n] = __builtin_amdgcn_mfma_f32_16x16x32_bf16(Bt[n][1], At[m][1], acc[ai][bj][m][n], 0, 0, 0); } } } \
        else { _Pragma("unroll") for (int m = 0; m < 4; ++m) _Pragma("unroll") for (int n = 0; n < 2; ++n) { \
            if constexpr (FP8) asm volatile("v_mfma_scale_f32_16x16x128_f8f6f4 %0, %1, %2, %0, %3, %4 op_sel_hi:[0,0,0]" : "+v"(acc[ai][bj][m][n]) : "v"(Bt##8[n]), "v"(At##8[m]), "v"((bj) ? sb1 : sb), "v"(sa)); \
            else { _Pragma("unroll") for (int k = 0; k < 2; ++k) acc[ai][bj][m][n] = __builtin_amdgcn_mfma_f32_16x16x32_bf16(Bt[n][k], At[m][k], acc[ai][bj][m][n], 0, 0, 0); } } } \
        __builtin_amdgcn_s_setprio(0); } while (0)
#define PG8_WAIT_V(n) asm volatile("s_waitcnt vmcnt(" #n ")" ::: "memory")
#define PG8_WAIT_L(n) asm volatile("s_waitcnt lgkmcnt(" #n ")" ::: "memory")
#define PG8_BAR __builtin_amdgcn_s_barrier()
#define PG8_SCHED __builtin_amdgcn_sched_barrier(0)
#define PG8_GOFF(dst, ui_) do { _Pragma("unroll") for (int _h = 0; _h < 2; ++_h) _Pragma("unroll") for (int _i = 0; _i < 2; ++_i) dst[_h][_i] = g.gidx[(ui_) * 256 + _h * HALF + RA[_i]] + (unsigned)CA[_i]; } while (0)
    Unit cur, nxt; int ui = 0;
    if (!S.next(0, cur)) return;
    f32x4 acc[2][2][4][2];
#define PG8_ZERO_ACC do { if constexpr (!FP8) { _Pragma("unroll") for (int a = 0; a < 2; ++a) _Pragma("unroll") for (int b = 0; b < 2; ++b) _Pragma("unroll") for (int m = 0; m < 4; ++m) _Pragma("unroll") for (int n = 0; n < 2; ++n) \
        acc[a][b][m][n] = (f32x4){0.f, 0.f, 0.f, 0.f}; } } while (0)
    PG8_ZERO_ACC;
    bf16x8 At[4][2], B0[2][2], B1[2][2]; i32x8 At8[4], B08[2], B18[2];
    unsigned oc[2][2], on[2][2];
    if constexpr (GATHER) { PG8_GOFF(oc, 0); PG8_WAIT_L(0); }
#pragma unroll
    for (int h = 0; h < 2; ++h)
#pragma unroll
        for (int i = 0; i < 2; ++i) { if constexpr (!GATHER) oc[h][i] = 0u; on[h][i] = oc[h][i]; }
    const char* cA = GATHER ? (const char*)g.A : (const char*)g.A + (size_t)cur.pm * tstep; const char* cB = (const char*)g.Bt + (size_t)cur.bt * tstep;
    PG8_STAGE(PG8_SB(0, 0), cB, voffB); PG8_STAGE(PG8_SB(0, 1), cB + hstepB, voffB); PG8_STAGE_A(PG8_SA(0, 0), cA, 0, false); PG8_STAGE_A(PG8_SA(0, 1), cA, 1, false);
    if (wr == 1) PG8_BAR;
    PG8_WAIT_V(2); PG8_BAR;
    PG8_STAGE(PG8_SB(1, 0), cB + kstep, voffB); PG8_STAGE_A(PG8_SA(1, 0), cA + kstep, 0, false); PG8_STAGE(PG8_SB(1, 1), cB + hstepB + kstep, voffB);
    PG8_WAIT_V(6); PG8_BAR;
    for (;;) {
        const bool has_next = S.next(ui + 1, nxt);
        const char* nA = GATHER ? cA : (has_next ? (const char*)g.A + (size_t)nxt.pm * tstep : cA); const char* nB = has_next ? (const char*)g.Bt + (size_t)nxt.bt * tstep : cB;
        if constexpr (GATHER) { if (has_next) { PG8_GOFF(on, ui + 1); } }
        for (int tt = 0; tt < nt * KREP; tt += 2) {
            const int t = KREP == 1 ? tt : tt % nt;
            const bool zf = FP8 && (tt == 0); const bool lastr = (t == nt - 2), last = lastr && (tt == nt * KREP - 2);
            const char* a1 = cA + (size_t)(t + 1) * kstep;
            const char* a2 = last ? nA : (lastr ? cA : cA + (size_t)(t + 2) * kstep); const char* b2 = last ? nB : (lastr ? cB : cB + (size_t)(t + 2) * kstep);
            const char* a3 = a2 + kstep; const char* b3 = b2 + kstep;
            PG8_LDB(B0, 0, 0); PG8_LDB(B1, 0, 1); PG8_SCHED; PG8_LDA(At, 0, 0); PG8_STAGE_A(PG8_SA(1, 1), a1, 1, false);
            PG8_WAIT_V(8); PG8_WAIT_L(0); PG8_BAR; PG8_MMA(0, 0, At, B0, zf); PG8_MMA(0, 1, At, B1, zf); PG8_BAR; PG8_SCHED;
            PG8_LDA(At, 0, 1); PG8_STAGE(PG8_SB(0, 0), b2, voffB); PG8_STAGE(PG8_SB(0, 1), b2 + hstepB, voffB); PG8_STAGE_A(PG8_SA(0, 0), a2, 0, last);
            PG8_WAIT_V(8); PG8_WAIT_L(0); PG8_BAR; PG8_MMA(1, 0, At, B0, zf); PG8_MMA(1, 1, At, B1, zf); PG8_BAR; PG8_SCHED;
            PG8_LDB(B0, 1, 0); PG8_LDB(B1, 1, 1); PG8_SCHED; PG8_LDA(At, 1, 0); PG8_STAGE_A(PG8_SA(0, 1), a2, 1, last);
            PG8_WAIT_V(8); PG8_WAIT_L(0); PG8_BAR; PG8_MMA(0, 0, At, B0, false); PG8_MMA(0, 1, At, B1, false); PG8_BAR; PG8_SCHED;
            PG8_LDA(At, 1, 1); PG8_STAGE(PG8_SB(1, 0), b3, voffB); PG8_STAGE(PG8_SB(1, 1), b3 + hstepB, voffB); PG8_STAGE_A(PG8_SA(1, 0), a3, 0, last);
            PG8_WAIT_V(8); PG8_WAIT_L(0); PG8_BAR; PG8_MMA(1, 0, At, B0, false); PG8_MMA(1, 1, At, B1, false); PG8_BAR; PG8_SCHED;
        }
        if (wr == 0) PG8_BAR;
        if constexpr (FP8) asm volatile("s_nop 15\n\ts_nop 15" ::: "memory");
        if constexpr (KREP > 1) {
#pragma unroll
            for (int a = 0; a < 2; ++a)
#pragma unroll
                for (int b = 0; b < 2; ++b)
#pragma unroll
                    for (int m = 0; m < 4; ++m)
#pragma unroll
                        for (int n = 0; n < 2; ++n) acc[a][b][m][n] = acc[a][b][m][n] * (1.0f / KREP); }
        E(acc, cur, wr, wc, fr, fq);
        if (!has_next) break;
        PG8_ZERO_ACC;
        cur = nxt; cA = nA; cB = nB; ++ui;
#pragma unroll
        for (int h = 0; h < 2; ++h)
#pragma unroll
            for (int i = 0; i < 2; ++i) oc[h][i] = on[h][i];
        if (wr == 1) PG8_BAR;
    }
    PG8_WAIT_V(0);
    PG8_BAR;
#undef PG8_SA
#undef PG8_SB
#undef PG8_STAGE
#undef PG8_STAGE_A
#undef PG8_LDA
#undef PG8_LDB
#undef PG8_MMA
#undef PG8_LD8
#undef PG8_WAIT_V
#undef PG8_WAIT_L
#undef PG8_BAR
#undef PG8_SCHED
#undef PG8_GOFF
#undef PG8_ZERO_ACC
}
}

namespace attn_body {
using bf16=__hip_bfloat16;
using bf16x8=__attribute__((ext_vector_type(8)))short;
using s16x4=__attribute__((ext_vector_type(4)))short;
using f32x16=__attribute__((ext_vector_type(16)))float;
using u32x4=__attribute__((ext_vector_type(4)))unsigned;
constexpr int BATCH=8,NHEAD=16,NKV=4,SEQ=4096,D=64,QP=NHEAD*D,KP=NKV*D;
constexpr int NW=8,QBLK=32,QB=QBLK*NW,KVBLK=64,NQB=SEQ/QB;
__device__ __forceinline__ int crow(int r,int hi){return (r&3)+8*(r>>2)+4*hi;}
#define SBAR() __builtin_amdgcn_sched_barrier(0)
constexpr int NSLOT=3, SLOTB=8192;
constexpr int LDS_K=0, LDS_V=NSLOT*SLOTB, LDS_WS=2*NSLOT*SLOTB, LDS_OST=LDS_WS+NW*64*4, LDS_BYTES=LDS_OST+NW*4096;
constexpr float C2=0.125f*1.4426950408889634f;
__device__ __forceinline__ void glds16(const void*gsrc,unsigned lds_dst){unsigned keep;
  asm volatile("s_mov_b32 %0, m0\n\ts_mov_b32 m0, %2\n\ts_nop 0\n\tglobal_load_lds_dwordx4 %1, off\n\ts_mov_b32 m0, %0":"=&s"(keep):"v"(gsrc),"s"(lds_dst):"memory");}
__device__ __forceinline__ float max3f(float a,float b,float c){float r;asm("v_max3_f32 %0, %1, %2, %3":"=v"(r):"v"(a),"v"(b),"v"(c));return r;}
__device__ __forceinline__ float max2f(float a,float b){float r;asm("v_max_f32_e32 %0, %1, %2":"=v"(r):"v"(a),"v"(b));return r;}
__device__ __forceinline__ float fadd_s(float a,float b){float r;asm("v_add_f32_e32 %0, %1, %2":"=v"(r):"v"(a),"v"(b));return r;}
__device__ __forceinline__ float fsub_s(float a,float b){float r;asm("v_sub_f32_e32 %0, %1, %2":"=v"(r):"v"(a),"v"(b));return r;}
typedef float f32x2_t __attribute__((ext_vector_type(2))); typedef __bf16 bf16x2_t __attribute__((ext_vector_type(2)));
__device__ __forceinline__ unsigned cvtpk_s(float lo,float hi){f32x2_t v={lo,hi};bf16x2_t b=__builtin_convertvector(v,bf16x2_t);return __builtin_bit_cast(unsigned,b);}
#define WAIT_BAR(N) asm volatile("s_waitcnt vmcnt(" #N ") lgkmcnt(0)\n\ts_barrier":::"memory")

__device__ __forceinline__ void qkt(f32x16&p0,f32x16&p1,const char*Kslot,const bf16x8*qr,const f32x16&negm,int r32,int hi){
  const char*kb=Kslot+hi*1024+r32*16;
  #pragma unroll
  for(int d0=0;d0<4;++d0){
    const bf16x8 b0=*reinterpret_cast<const bf16x8*>(kb+d0*2048);
    const bf16x8 b1=*reinterpret_cast<const bf16x8*>(kb+d0*2048+512);
    if(d0==0){p0=__builtin_amdgcn_mfma_f32_32x32x16_bf16(b0,qr[0],negm,0,0,0);p1=__builtin_amdgcn_mfma_f32_32x32x16_bf16(b1,qr[0],negm,0,0,0);}
    else{p0=__builtin_amdgcn_mfma_f32_32x32x16_bf16(b0,qr[d0],p0,0,0,0);p1=__builtin_amdgcn_mfma_f32_32x32x16_bf16(b1,qr[d0],p1,0,0,0);}}
}
typedef __attribute__((address_space(3))) const char* lds_cptr;
typedef short v4i16_t __attribute__((ext_vector_type(4)));
__device__ __forceinline__ void kload8(bf16x8*kf,lds_cptr kp){
  kf[0]=*(const __attribute__((address_space(3))) bf16x8*)(kp);      kf[1]=*(const __attribute__((address_space(3))) bf16x8*)(kp+512);
  kf[2]=*(const __attribute__((address_space(3))) bf16x8*)(kp+2048); kf[3]=*(const __attribute__((address_space(3))) bf16x8*)(kp+2560);
  kf[4]=*(const __attribute__((address_space(3))) bf16x8*)(kp+4096); kf[5]=*(const __attribute__((address_space(3))) bf16x8*)(kp+4608);
  kf[6]=*(const __attribute__((address_space(3))) bf16x8*)(kp+6144); kf[7]=*(const __attribute__((address_space(3))) bf16x8*)(kp+6656);
}
__device__ __forceinline__ void kload2(bf16x8*kf,lds_cptr kp,int j){ kf[2*j]=*(const __attribute__((address_space(3))) bf16x8*)(kp+j*2048); kf[2*j+1]=*(const __attribute__((address_space(3))) bf16x8*)(kp+j*2048+512); }
__device__ __forceinline__ s16x4 vtr(lds_cptr p){ return __builtin_bit_cast(s16x4,__builtin_amdgcn_ds_read_tr16_b64_v4i16((__attribute__((address_space(3))) v4i16_t*)p)); }
__device__ __forceinline__ float rowmax(const f32x16&p0,const f32x16&p1){
  float a=max3f(p0[0],p0[1],p1[0]),b=max3f(p0[2],p0[3],p1[1]);a=max3f(a,p1[2],p1[3]);
  #pragma unroll
  for(int r=4;r<16;r+=4){a=max3f(a,p0[r],p0[r+1]);b=max3f(b,p0[r+2],p0[r+3]);a=max3f(a,p1[r],p1[r+1]);b=max3f(b,p1[r+2],p1[r+3]);}
  const float m=max2f(a,b);
  auto rr=__builtin_amdgcn_permlane32_swap(__float_as_uint(m),__float_as_uint(m),false,false);
  return max2f(__uint_as_float(rr[0]),__uint_as_float(rr[1]));
}
__device__ __forceinline__ void pv(f32x16*o,int vb,bf16x8 pa0,bf16x8 pa1,bf16x8 pa2,bf16x8 pa3){
  #pragma unroll
  for(int d0=0;d0<2;++d0){s16x4 lo[4],hi[4];
    #pragma unroll
    for(int ks=0;ks<4;++ks){
      asm volatile("ds_read_b64_tr_b16 %0,%1 offset:%c2":"=&v"(lo[ks]):"v"(vb),"i"(d0*4096+ks*1024):"memory");
      asm volatile("ds_read_b64_tr_b16 %0,%1 offset:%c2":"=&v"(hi[ks]):"v"(vb),"i"(d0*4096+ks*1024+512):"memory");}
    asm volatile("s_waitcnt lgkmcnt(0)":::"memory");SBAR();
    #define PK(k) (bf16x8){lo[k][0],lo[k][1],lo[k][2],lo[k][3],hi[k][0],hi[k][1],hi[k][2],hi[k][3]}
    o[d0]=__builtin_amdgcn_mfma_f32_32x32x16_bf16(pa0,PK(0),o[d0],0,0,0);
    o[d0]=__builtin_amdgcn_mfma_f32_32x32x16_bf16(pa1,PK(1),o[d0],0,0,0);
    o[d0]=__builtin_amdgcn_mfma_f32_32x32x16_bf16(pa2,PK(2),o[d0],0,0,0);
    o[d0]=__builtin_amdgcn_mfma_f32_32x32x16_bf16(pa3,PK(3),o[d0],0,0,0);
    #undef PK
  }
}
#define ATTN_STORE16(p,v) (*(u32x4*)(p)=(v))
template<int THRL> __device__ __forceinline__ void attn_unit(int b,int h,int qb,const bf16*Q,const bf16*__restrict__ K,const bf16*__restrict__ V,bf16*O,char*shm){
  const int tid=threadIdx.x,lane=tid&63,r32=lane&31,hi=lane>>5; const int wid=__builtin_amdgcn_readfirstlane(tid>>6);
  const long rowbase=(long)b*SEQ; const int q0=qb*QB; const int kvh=h/(NHEAD/NKV);
  const bf16*Qw=Q+(rowbase+q0+wid*QBLK)*QP+h*D;
  const bf16*Kh=K+rowbase*KP+kvh*D,*Vh=V+rowbase*KP+kvh*D;
  const unsigned lds0=(unsigned)(uintptr_t)shm;
  float*wsf=(float*)(shm+LDS_WS)+wid*64;
  const bf16*ksrc=Kh+(long)lane*KP+wid*8;
  const bf16*vsrc=Vh+(long)(16*(wid&3)+(lane>>2))*KP+(wid>>2)*32+(lane&3)*8;
  const unsigned kdst=lds0+LDS_K+wid*1024, vdst=lds0+LDS_V+wid*1024;
  #define DMA_K(t,slot) glds16(ksrc+(long)(t)*KVBLK*KP,(unsigned)__builtin_amdgcn_readfirstlane(kdst+(slot)))
  #define DMA_V(t,slot) glds16(vsrc+(long)(t)*KVBLK*KP,(unsigned)__builtin_amdgcn_readfirstlane(vdst+(slot)))
  const int vb0=(int)(lds0+LDS_V)+((lane>>4)&1)*32+(lane&3)*8+(4*hi+((lane&15)>>2))*64;
  const char*Kbase=shm+LDS_K; bf16x8 kf[8];
  const lds_cptr shm3=(lds_cptr)shm; const lds_cptr kp0=shm3+LDS_K+hi*1024+r32*16; const lds_cptr vp0=shm3+LDS_V+((lane>>4)&1)*32+(lane&3)*8+(4*hi+((lane&15)>>2))*64;
  constexpr int NT=SEQ/KVBLK;
  DMA_K(0,0);DMA_V(0,0);DMA_K(1,SLOTB);
  bf16x8 qr[4];
  #pragma unroll
  for(int d0=0;d0<4;++d0)qr[d0]=*reinterpret_cast<const bf16x8*>(&Qw[(long)r32*QP+d0*16+hi*8]);
  float mhat=0.f,l_reg=0.f;f32x16 o[2];o[0]=f32x16{};o[1]=f32x16{};f32x16 negm=f32x16{};asm volatile("":"+v"(negm));
  bool resc=false;
  #define START(P0,P1) do{ const float rm=rowmax(P0,P1); resc=false; \
    { const float dl=rm; mhat=fadd_s(mhat,dl); \
      _Pragma("unroll") for(int r=0;r<16;++r){P0[r]=fsub_s(P0[r],dl);P1[r]=fsub_s(P1[r],dl);} \
      _Pragma("unroll") for(int r=0;r<16;++r)negm[r]=-mhat; asm volatile("":"+v"(negm)); } \
    _Pragma("unroll") for(int r=0;r<16;++r)P0[r]=__builtin_amdgcn_exp2f(P0[r]); }while(0)
  #define RESC() do{ if(resc){ asm volatile("s_waitcnt lgkmcnt(0)":::"memory"); \
      _Pragma("unroll") for(int d_=0;d_<2;++d_) _Pragma("unroll") for(int r=0;r<16;++r)o[d_][r]*=wsf[crow(r,hi)]; } }while(0)
  f32x16 pA0,pA1,pB0,pB1;
  int sl_prev=0,sl_cur=0,sl_next=SLOTB;
  #define ROT() do{sl_prev=sl_cur;sl_cur=sl_next;sl_next=(sl_next==(NSLOT-1)*SLOTB)?0:sl_next+SLOTB;}while(0)
  DMA_K(2,2*SLOTB);
  WAIT_BAR(3);
  qkt(pA0,pA1,Kbase,qr,negm,r32,hi);asm volatile("s_nop 15\n\ts_nop 7":"+v"(pA0),"+v"(pA1));
  START(pA0,pA1);
  _Pragma("unroll") for(int r=0;r<16;++r)pA1[r]=__builtin_amdgcn_exp2f(pA1[r]);
  WAIT_BAR(0);
  DMA_K(3,0);DMA_V(1,SLOTB);
  ROT();
  kload8(kf,kp0+sl_cur);
  WAIT_BAR(2);
  s16x4 vlo[8],vhi[8]; u32x4 pw0,pw1,pw2,pw3;
  #define PKW(P,B) cvtpk_s(P[B],P[B+1])
  #define PAF(k) __builtin_bit_cast(bf16x8,pw##k)
  #define VFR(i) (bf16x8){vlo[i][0],vlo[i][1],vlo[i][2],vlo[i][3],vhi[i][0],vhi[i][1],vhi[i][2],vhi[i][3]}
  #define PIN(x) asm volatile("":"+v"(x))
  #define MX3(a,b,c) __builtin_fmaxf(__builtin_fmaxf((a),(b)),(c))
  #define GAPA(MF,A0,A1,A2,A3,W0,W1,PW) do{ MF; sacc+=A0; sacc+=A1; sacc+=A2; sacc+=A3; PIN(sacc); W0; W1; PIN(PW); SBAR(); }while(0)
  #define EX(v) __builtin_amdgcn_exp2f(v)
  #define GAPB(MF,X,B) do{ MF; X[B]=EX(X[B]); X[B+1]=EX(X[B+1]); X[B+2]=EX(X[B+2]); X[B+3]=EX(X[B+3]); PIN(X); SBAR(); }while(0)
  #define VRD(i) do{ vlo[i]=vtr(vp_+(((i)>>2)*4096+((i)&3)*1024)); vhi[i]=vtr(vp_+(((i)>>2)*4096+((i)&3)*1024+512)); }while(0)
  #define KRD(G,j) do{ if(G){ kload2(kf,kp0+sl_next,j); SBAR(); } }while(0)
  #define STEP(C0,C1,P0,P1,t,GK,GV,GL) do{ SBAR(); \
    const lds_cptr vp_=vp0+sl_prev; \
    VRD(0); SBAR(); float sacc=(P0[0]+P0[1]); \
    GAPA(C0=__builtin_amdgcn_mfma_f32_32x32x16_bf16(kf[0],qr[0],negm,0,0,0), P0[2],P0[3],P0[4],P0[5],     pw0[0]=PKW(P0,0), pw0[1]=PKW(P0,2), pw0); \
    VRD(4); SBAR(); GAPA(C1=__builtin_amdgcn_mfma_f32_32x32x16_bf16(kf[1],qr[0],negm,0,0,0), P0[6],P0[7],P0[8],P0[9],     pw0[2]=PKW(P0,4), pw0[3]=PKW(P0,6), pw0); \
    VRD(1); SBAR(); GAPA(C0=__builtin_amdgcn_mfma_f32_32x32x16_bf16(kf[2],qr[1],C0,0,0,0),   P0[10],P0[11],P0[12],P0[13], pw1[0]=PKW(P0,8), pw1[1]=PKW(P0,10), pw1); \
    VRD(5); SBAR(); GAPA(C1=__builtin_amdgcn_mfma_f32_32x32x16_bf16(kf[3],qr[1],C1,0,0,0),   P0[14],P0[15],P1[0],P1[1],   pw1[2]=PKW(P0,12),pw1[3]=PKW(P0,14), pw1); \
    VRD(2); SBAR(); GAPA(C0=__builtin_amdgcn_mfma_f32_32x32x16_bf16(kf[4],qr[2],C0,0,0,0),   P1[2],P1[3],P1[4],P1[5],     pw2[0]=PKW(P1,0), pw2[1]=PKW(P1,2), pw2); \
    VRD(6); SBAR(); GAPA(C1=__builtin_amdgcn_mfma_f32_32x32x16_bf16(kf[5],qr[2],C1,0,0,0),   P1[6],P1[7],P1[8],P1[9],     pw2[2]=PKW(P1,4), pw2[3]=PKW(P1,6), pw2); \
    VRD(3); SBAR(); GAPA(C0=__builtin_amdgcn_mfma_f32_32x32x16_bf16(kf[6],qr[3],C0,0,0,0),   P1[10],P1[11],P1[12],P1[13], pw3[0]=PKW(P1,8), pw3[1]=PKW(P1,10), pw3); \
    VRD(7); SBAR(); GAPA(C1=__builtin_amdgcn_mfma_f32_32x32x16_bf16(kf[7],qr[3],C1,0,0,0),   P1[14],P1[15],0.f,0.f,       pw3[2]=PKW(P1,12),pw3[3]=PKW(P1,14), pw3); \
    l_reg+=sacc; \
    if(GK){DMA_K((t)+3,sl_cur);} if(GV){DMA_V((t)+1,sl_next);} \
    { float a=MX3(C0[0],C0[1],C1[0]),b=MX3(C0[2],C0[3],C1[1]); a=MX3(a,C1[2],C1[3]); \
      _Pragma("unroll") for(int r=4;r<16;r+=4){a=MX3(a,C0[r],C0[r+1]);b=MX3(b,C0[r+2],C0[r+3]);a=MX3(a,C1[r],C1[r+1]);b=MX3(b,C1[r+2],C1[r+3]);} \
      float rm=__builtin_fmaxf(a,b); { auto rr=__builtin_amdgcn_permlane32_swap(__float_as_uint(rm),__float_as_uint(rm),false,false); rm=__builtin_fmaxf(__uint_as_float(rr[0]),__uint_as_float(rr[1])); } \
      resc=false; \
      if(__builtin_expect(__any(rm>(float)THRL),0)){ const float dl=__builtin_fmaxf(rm,0.f); mhat+=dl; \
        _Pragma("unroll") for(int r=0;r<16;++r){C0[r]-=dl;C1[r]-=dl;} \
        _Pragma("unroll") for(int r=0;r<16;++r)negm[r]=-mhat; asm volatile("":"+v"(negm)); \
        const float f=__builtin_amdgcn_exp2f(-dl); l_reg*=f; if(hi==0)wsf[r32]=f; resc=true; } } \
    SBAR(); \
    GAPB(o[0]=__builtin_amdgcn_mfma_f32_32x32x16_bf16(PAF(0),VFR(0),o[0],0,0,0), C0,0); \
    GAPB(o[1]=__builtin_amdgcn_mfma_f32_32x32x16_bf16(PAF(0),VFR(4),o[1],0,0,0), C0,4); \
    KRD(GL,0); GAPB(o[0]=__builtin_amdgcn_mfma_f32_32x32x16_bf16(PAF(1),VFR(1),o[0],0,0,0), C0,8); \
    KRD(GL,1); GAPB(o[1]=__builtin_amdgcn_mfma_f32_32x32x16_bf16(PAF(1),VFR(5),o[1],0,0,0), C0,12); \
    KRD(GL,2); GAPB(o[0]=__builtin_amdgcn_mfma_f32_32x32x16_bf16(PAF(2),VFR(2),o[0],0,0,0), C1,0); \
    KRD(GL,3); GAPB(o[1]=__builtin_amdgcn_mfma_f32_32x32x16_bf16(PAF(2),VFR(6),o[1],0,0,0), C1,4); \
    GAPB(o[0]=__builtin_amdgcn_mfma_f32_32x32x16_bf16(PAF(3),VFR(3),o[0],0,0,0), C1,8); \
    GAPB(o[1]=__builtin_amdgcn_mfma_f32_32x32x16_bf16(PAF(3),VFR(7),o[1],0,0,0), C1,12); \
    }while(0)
  int t=1;
  for(;t+5<NT;t+=2){
    STEP(pB0,pB1,pA0,pA1,t,true,true,true);     WAIT_BAR(2); RESC(); ROT();
    STEP(pA0,pA1,pB0,pB1,t+1,true,true,true);   WAIT_BAR(2); RESC(); ROT();
  }
  #define ENDW(tt) do{ if((tt)+3<NT){WAIT_BAR(2);} else if((tt)+2<NT){WAIT_BAR(1);} else {WAIT_BAR(0);} }while(0)
  for(;t+1<NT;t+=2){
    STEP(pB0,pB1,pA0,pA1,t,(t+3<NT),(t+1<NT),(t+1<NT));       ENDW(t);   RESC(); ROT();
    STEP(pA0,pA1,pB0,pB1,t+1,(t+4<NT),(t+2<NT),(t+2<NT));     ENDW(t+1); RESC(); ROT();
  }
  STEP(pB0,pB1,pA0,pA1,NT-1,false,false,false); RESC();
  { float sacc=pB0[0]+pB0[1]; _Pragma("unroll") for(int r=2;r<16;++r)sacc+=pB0[r]; _Pragma("unroll") for(int r=0;r<16;++r)sacc+=pB1[r]; l_reg+=sacc;
    pw0=(u32x4){PKW(pB0,0),PKW(pB0,2),PKW(pB0,4),PKW(pB0,6)};pw1=(u32x4){PKW(pB0,8),PKW(pB0,10),PKW(pB0,12),PKW(pB0,14)};pw2=(u32x4){PKW(pB1,0),PKW(pB1,2),PKW(pB1,4),PKW(pB1,6)};pw3=(u32x4){PKW(pB1,8),PKW(pB1,10),PKW(pB1,12),PKW(pB1,14)};
    SBAR(); pv(o,vb0+sl_cur,PAF(0),PAF(1),PAF(2),PAF(3)); }
  #undef PKW
  #undef PAF
  #undef VFR
  #undef PIN
  #undef MX3
  #undef GAPA
  #undef GAPB
  #undef EX
  #undef VRD
  #undef KRD
  #undef STEP
  #undef ENDW
  {auto rr=__builtin_amdgcn_permlane32_swap(__float_as_uint(l_reg),__float_as_uint(l_reg),false,false);l_reg=__uint_as_float(rr[0])+__uint_as_float(rr[1]);}
  if(hi==0)wsf[32+r32]=l_reg;asm volatile("s_waitcnt lgkmcnt(0)":::"memory");
  float rli[16];
  #pragma unroll
  for(int r=0;r<16;++r)rli[r]=__builtin_amdgcn_rcpf(wsf[32+crow(r,hi)]);
  bf16*Ow=O+(rowbase+q0+wid*QBLK)*QP+h*D;
  { bf16*stg=(bf16*)(shm+LDS_OST)+wid*2048;
    #pragma unroll
    for(int r=0;r<16;++r){const int orow=crow(r,hi);
      #pragma unroll
      for(int d0=0;d0<2;++d0)stg[orow*64+d0*32+r32]=__float2bfloat16(o[d0][r]*rli[r]);}
    asm volatile("s_waitcnt lgkmcnt(0)":::"memory");
    #pragma unroll
    for(int i=0;i<4;++i){const int row=i*8+(lane>>3),ch=lane&7; const u32x4 v=*(const u32x4*)(stg+row*64+ch*8); ATTN_STORE16(Ow+(long)row*QP+ch*8,v);} }
  asm volatile("s_waitcnt lgkmcnt(0)\n\ts_barrier":::"memory");
  #undef DMA_K
  #undef DMA_V
  #undef START
  #undef RESC
  #undef ROT
}
constexpr int ATTN_LDS_BYTES=LDS_BYTES;
#undef SBAR
#undef WAIT_BAR
}

namespace attn8 {
using bf16=__hip_bfloat16;
using f32x16=__attribute__((ext_vector_type(16)))float;
using u32x4=__attribute__((ext_vector_type(4)))unsigned;
using i32x4=__attribute__((ext_vector_type(4)))int;
using i32x8=__attribute__((ext_vector_type(8)))int;
constexpr int SEQ=4096,NT=SEQ/64,NW=8;
constexpr int NSL=8;
constexpr int LDS_K=0, LDS_V=NSL*4096, LDS_OST=2*NSL*4096, LDS_BYTES=LDS_OST+NW*2048, LDS_SIDE=LDS_BYTES;
constexpr int E8_Q=0x79797979, E8_K=0x7B7B7B7B, E8_V=0x7B7B7B7B, E8_1=0x7F7F7F7F;
constexpr float SQ=64.f*0.125f*1.4426950408889634f, SK=16.f, SV=16.f, SO=64.f;
constexpr int E8_O=0x79797979;
__device__ __forceinline__ int crow(int r,int hi){return (r&3)+8*(r>>2)+4*hi;}
__device__ __forceinline__ void glds16(const void*gsrc,unsigned lds_dst){unsigned keep;
  asm volatile("s_mov_b32 %0, m0\n\ts_mov_b32 m0, %2\n\ts_nop 0\n\tglobal_load_lds_dwordx4 %1, off\n\ts_mov_b32 m0, %0":"=&s"(keep):"v"(gsrc),"s"(lds_dst):"memory");}
__device__ __forceinline__ void glds16s(const void*sbase,unsigned voff,unsigned lds_dst){unsigned keep;
  asm volatile("s_mov_b32 %0, m0\n\ts_mov_b32 m0, %3\n\ts_nop 0\n\tglobal_load_lds_dwordx4 %1, %2\n\ts_mov_b32 m0, %0":"=&s"(keep):"v"(voff),"s"(sbase),"s"(lds_dst):"memory");}
typedef __attribute__((address_space(3))) const char* lds_cptr;
typedef short v4i16_t __attribute__((ext_vector_type(4)));
typedef unsigned u32x2 __attribute__((ext_vector_type(2)));
__device__ __forceinline__ u32x2 vtr(lds_cptr p){ return __builtin_bit_cast(u32x2,__builtin_amdgcn_ds_read_tr16_b64_v4i16((__attribute__((address_space(3))) v4i16_t*)p)); }
__device__ __forceinline__ i32x8 ld32(lds_cptr p0,lds_cptr p1){ return __builtin_shufflevector(*(const __attribute__((address_space(3))) i32x4*)p0,*(const __attribute__((address_space(3))) i32x4*)p1,0,1,2,3,4,5,6,7); }
#define pk2f8(a,b,old,hiw) __builtin_amdgcn_cvt_pk_fp8_f32(a,b,old,hiw)
#define A8_WAIT_BAR(N) asm volatile("s_waitcnt vmcnt(" #N ") lgkmcnt(0)\n\ts_barrier":::"memory")
#define A8_SS_END(allow) do{ const int c_=side.end(lane,allow); if(c_==2){A8_WAIT_BAR(4);} else if(c_==1){A8_WAIT_BAR(3);} else {A8_WAIT_BAR(2);} }while(0)
#define A8_MFMA(A,B,C,SA,SB) __builtin_amdgcn_mfma_scale_f32_32x32x64_f8f6f4(A,B,C,0,0,0,SA,0,SB)

template<int THRL,class Side> __device__ __forceinline__ void attn_unit(Side&side,int b,int h,int qb,bool first,bool has_next,int nb,int nh,int nqb,i32x8&qf,const unsigned char*Q8,const unsigned char*__restrict__ K8,const unsigned char*__restrict__ V8p,bf16*O,char*shm,float sc){
  const int tid=threadIdx.x,lane=tid&63,r32=lane&31,hi=lane>>5; const int wid=__builtin_amdgcn_readfirstlane(tid>>6);
  const long rowbase=(long)b*SEQ; const int q0=qb*256; const int kvh=h>>2;
  sc=__int_as_float(__builtin_amdgcn_readfirstlane(__float_as_int(sc)));
  const unsigned lds0=(unsigned)(uintptr_t)shm;
  const lds_cptr shm3=(lds_cptr)shm;
  const bool kw=wid<4; const int w4=wid&3, P=64*w4+lane;
  const unsigned char*sbase; unsigned soff; long dn;
  { const int hb=P&1,q_=P>>1,l=q_&63,blk=q_>>6,hi_=l>>5,r=l&31,half=hb^((l>>3)&1);
    const int j=P>>3,cs=P&7,c=cs^(((j>>2)&1)<<2);
    const size_t ko=(size_t)(blk*32+r)*256+32*hi_+16*half, vo=((size_t)j*256+8*c)*2;
    sbase=kw?K8+(size_t)rowbase*256+kvh*64:V8p+((size_t)(rowbase/2)*256+kvh*64)*2; soff=(unsigned)(kw?ko:vo);
    const long nrb=(long)nb*SEQ; const int nkvh=nh>>2;
    dn=(nrb-rowbase)*256+(long)(nkvh-kvh)*(kw?64:128); }
  const unsigned dst0=lds0+(kw?LDS_K:LDS_V)+w4*1024; const int ahead=kw?5:3;
  #define A8_DMA(tile,slot) glds16s(sbase+(size_t)(tile)*16384,soff,(unsigned)__builtin_amdgcn_readfirstlane(dst0+(unsigned)(slot)*4096u))
  #define A8_DMA_N(tile,slot) glds16s(sbase+(has_next?dn+(long)(tile)*16384:(long)(NT-1)*16384),soff,(unsigned)__builtin_amdgcn_readfirstlane(dst0+(unsigned)(slot)*4096u))
  if(first){
    int lf=lane; asm volatile("":"+v"(lf)); const unsigned char*qp=Q8+(size_t)(rowbase+q0+wid*32+(lf&31))*1024+h*64+32*(lf>>5);
    qf=__builtin_shufflevector(*(const i32x4*)qp,*(const i32x4*)(qp+16),0,1,2,3,4,5,6,7);
    asm volatile("s_waitcnt vmcnt(0)":"+v"(qf)::"memory");
    A8_DMA(0,0);A8_DMA(1,1);A8_DMA(2,2);A8_DMA(3,3);A8_DMA(kw?4:3,kw?4:3);A8_DMA(kw?5:3,kw?5:3);
  } else { A8_DMA(kw?5:3,kw?5:3); }
  const unsigned kq0=(unsigned)(uintptr_t)shm+LDS_K+lane*32+16*((lane>>3)&1);
  const int q4=(lane&15)>>2,p4=lane&3,g1=(lane>>4)&1,x=(q4>>1)&1;
  const unsigned vq0=(unsigned)(uintptr_t)shm+LDS_V+(2*hi+(q4&1)+4*(q4>>1))*128+(((2*g1+(p4>>1))^(x<<2))*16)+8*(p4&1);
  #define A8_LP(u) ((lds_cptr)(uintptr_t)(u))
  f32x16 o[2],os;o[0]=f32x16{};o[1]=f32x16{};os=f32x16{};
  const f32x16 zero16=f32x16{};
  int one4=0x38383838; asm volatile("":"+s"(one4));
  i32x8 ones=(i32x8){one4,one4,one4,one4,one4,one4,one4,one4};
  asm volatile("":"+v"(ones));
  i32x8 kf[2]; f32x16 pA0,pA1;
  typedef short v2i16_t __attribute__((ext_vector_type(2)));
  #define A8_MFMA_P(A,B,C,SB) __builtin_amdgcn_mfma_scale_f32_32x32x64_f8f6f4(A,B,C,1,0,0,E8_1,0,SB)
  #define A8_KLOAD(slot) do{ const lds_cptr kp0=A8_LP(kq0),kp1=A8_LP(kq0^16u); kf[0]=ld32(kp0+(slot)*4096,kp1+(slot)*4096); kf[1]=ld32(kp0+(slot)*4096+2048,kp1+(slot)*4096+2048); }while(0)
  #define A8_CV(E,i,hiw,old) __builtin_amdgcn_cvt_scalef32_pk_bf8_f32(old,E[i],E[(i)+1],sc,hiw)
  #define A8_PACK(pw,E0,E1) do{ v2i16_t u0_,u1_,u2_,u3_,u4_,u5_,u6_,u7_; asm volatile("":"=v"(u0_),"=v"(u1_),"=v"(u2_),"=v"(u3_),"=v"(u4_),"=v"(u5_),"=v"(u6_),"=v"(u7_)); \
      u0_=A8_CV(E0,0,false,u0_);u0_=A8_CV(E0,2,true,u0_); u1_=A8_CV(E0,4,false,u1_);u1_=A8_CV(E0,6,true,u1_); u2_=A8_CV(E0,8,false,u2_);u2_=A8_CV(E0,10,true,u2_); u3_=A8_CV(E0,12,false,u3_);u3_=A8_CV(E0,14,true,u3_); \
      u4_=A8_CV(E1,0,false,u4_);u4_=A8_CV(E1,2,true,u4_); u5_=A8_CV(E1,4,false,u5_);u5_=A8_CV(E1,6,true,u5_); u6_=A8_CV(E1,8,false,u6_);u6_=A8_CV(E1,10,true,u6_); u7_=A8_CV(E1,12,false,u7_);u7_=A8_CV(E1,14,true,u7_); \
      pw=(i32x8){__builtin_bit_cast(int,u0_),__builtin_bit_cast(int,u1_),__builtin_bit_cast(int,u2_),__builtin_bit_cast(int,u3_),__builtin_bit_cast(int,u4_),__builtin_bit_cast(int,u5_),__builtin_bit_cast(int,u6_),__builtin_bit_cast(int,u7_)}; }while(0)
  #define A8_VLOAD(vf0,vf1,slot) do{ const lds_cptr va_=A8_LP(vq0)+(slot)*4096, vb_=A8_LP(vq0^64u)+(slot)*4096; \
      const u32x2 a0=vtr(va_),a1=vtr(va_+1024),a2=vtr(va_+2048),a3=vtr(va_+3072),b0=vtr(vb_),b1=vtr(vb_+1024),b2=vtr(vb_+2048),b3=vtr(vb_+3072); \
      vf0=(i32x8){(int)a0.x,(int)a0.y,(int)a1.x,(int)a1.y,(int)a2.x,(int)a2.y,(int)a3.x,(int)a3.y}; vf1=(i32x8){(int)b0.x,(int)b0.y,(int)b1.x,(int)b1.y,(int)b2.x,(int)b2.y,(int)b3.x,(int)b3.y}; }while(0)
  if(first){ A8_WAIT_BAR(5); }
  A8_KLOAD(0);
  pA0=A8_MFMA(kf[0],qf,zero16,E8_K,E8_Q); pA1=A8_MFMA(kf[1],qf,zero16,E8_K,E8_Q);
  #define A8_MPART_S(t,sv,sk) do{ i32x8 vf0,vf1,pw; \
    A8_VLOAD(vf0,vf1,sv); \
    A8_PACK(pw,pA0,pA1); \
    pA0=A8_MFMA(kf[0],qf,zero16,E8_K,E8_Q); pA1=A8_MFMA(kf[1],qf,zero16,E8_K,E8_Q); \
    A8_KLOAD(sk);                                       \
    { const int ta_=(t)+ahead; if(ta_<NT){ A8_DMA(ta_,ta_&(NSL-1)); } else { A8_DMA_N(ta_-NT,ta_&(NSL-1)); } } \
    o[0]=A8_MFMA_P(pw,vf0,o[0],E8_V); o[1]=A8_MFMA_P(pw,vf1,o[1],E8_V); os=A8_MFMA_P(pw,ones,os,E8_1); }while(0)
  #define A8_MPART(t) A8_MPART_S(t,((t)-1)&(NSL-1),((t)+1)&(NSL-1))
  #define A8_VPART() do{ _Pragma("unroll") for(int r=0;r<16;++r){pA0[r]=__builtin_amdgcn_exp2f(pA0[r]);pA1[r]=__builtin_amdgcn_exp2f(pA1[r]);} asm volatile("":"+v"(pA0),"+v"(pA1),"+v"(o[0]),"+v"(o[1]),"+v"(os)); }while(0)
  if(wid<4){
    A8_VPART();
    if(first){ A8_WAIT_BAR(2); }
    A8_KLOAD(1);
#pragma unroll 1
    for(int t0=1;t0<=NT-15;t0+=8){
      side.begin(lane); A8_MPART_S(t0,0,2); A8_VPART(); A8_MPART_S(t0+1,1,3); A8_VPART(); A8_SS_END(true);
      side.begin(lane); A8_MPART_S(t0+2,2,4); A8_VPART(); A8_MPART_S(t0+3,3,5); A8_VPART(); A8_SS_END(true);
      side.begin(lane); A8_MPART_S(t0+4,4,6); A8_VPART(); A8_MPART_S(t0+5,5,7); A8_VPART(); A8_SS_END(true);
      side.begin(lane); A8_MPART_S(t0+6,6,0); A8_VPART(); A8_MPART_S(t0+7,7,1); A8_VPART(); A8_SS_END(true);
    }
    side.begin(lane); A8_MPART(NT-7); A8_VPART(); A8_MPART(NT-6); A8_VPART(); A8_SS_END(true);
    side.begin(lane); A8_MPART(NT-5); A8_VPART(); A8_MPART(NT-4); A8_VPART(); A8_SS_END(false);
    side.begin(lane); A8_MPART(NT-3); A8_VPART(); A8_MPART(NT-2); A8_VPART(); A8_SS_END(false);
    side.begin(lane); A8_MPART(NT-1); A8_VPART(); A8_SS_END(false);
  } else {
    if(first){ A8_WAIT_BAR(2); }
    A8_KLOAD(1);
#pragma unroll 1
    for(int t0=1;t0<=NT-15;t0+=8){
      side.begin(lane); A8_VPART(); A8_MPART_S(t0,0,2); A8_VPART(); A8_MPART_S(t0+1,1,3); A8_SS_END(true);
      side.begin(lane); A8_VPART(); A8_MPART_S(t0+2,2,4); A8_VPART(); A8_MPART_S(t0+3,3,5); A8_SS_END(true);
      side.begin(lane); A8_VPART(); A8_MPART_S(t0+4,4,6); A8_VPART(); A8_MPART_S(t0+5,5,7); A8_SS_END(true);
      side.begin(lane); A8_VPART(); A8_MPART_S(t0+6,6,0); A8_VPART(); A8_MPART_S(t0+7,7,1); A8_SS_END(true);
    }
    side.begin(lane); A8_VPART(); A8_MPART(NT-7); A8_VPART(); A8_MPART(NT-6); A8_SS_END(true);
    side.begin(lane); A8_VPART(); A8_MPART(NT-5); A8_VPART(); A8_MPART(NT-4); A8_SS_END(false);
    side.begin(lane); A8_VPART(); A8_MPART(NT-3); A8_VPART(); A8_MPART(NT-2); A8_SS_END(false);
    side.begin(lane); A8_VPART(); A8_MPART(NT-1); A8_SS_END(false);
    A8_VPART();
  }
  i32x8 qn=qf;
  if(has_next){ int lq=lane; asm volatile("":"+v"(lq)); const unsigned char*qp=Q8+(size_t)((long)nb*SEQ+nqb*256+wid*32+(lq&31))*1024+nh*64+32*(lq>>5);
    qn=__builtin_shufflevector(*(const i32x4*)qp,*(const i32x4*)(qp+16),0,1,2,3,4,5,6,7); }
  { i32x8 vf0,vf1,pw; A8_VLOAD(vf0,vf1,(NT-1)&(NSL-1)); A8_PACK(pw,pA0,pA1);
    o[0]=A8_MFMA_P(pw,vf0,o[0],E8_V); o[1]=A8_MFMA_P(pw,vf1,o[1],E8_V); os=A8_MFMA_P(pw,ones,os,E8_1); }
  int lane2=lane; asm volatile("":"+v"(lane2)); const int r32b=lane2&31,hib=lane2>>5;
  float rli[16];
  #pragma unroll
  for(int r=0;r<16;++r)rli[r]=__builtin_amdgcn_rcpf(os[r]);
  unsigned char*Ow=(unsigned char*)O+(size_t)(rowbase+q0+wid*32)*1024+h*64;
  { unsigned char*stg=(unsigned char*)(shm+LDS_OST)+wid*2048;
    #pragma unroll
    for(int r=0;r<16;r+=2){
      #pragma unroll
      for(int d0=0;d0<2;++d0){ const int w_=__builtin_amdgcn_cvt_pk_fp8_f32(__builtin_fminf(__builtin_fmaxf(o[d0][r]*rli[r]*SO,-448.f),448.f),__builtin_fminf(__builtin_fmaxf(o[d0][r+1]*rli[r+1]*SO,-448.f),448.f),0,false);
        stg[crow(r,hib)*64+d0*32+r32b]=(unsigned char)(w_&0xff); stg[crow(r+1,hib)*64+d0*32+r32b]=(unsigned char)((w_>>8)&0xff); } }
    asm volatile("s_waitcnt lgkmcnt(0)":::"memory");
    #pragma unroll
    for(int i=0;i<2;++i){const int row=i*16+(lane2>>2),ch=lane2&3; const u32x4 v=*(const u32x4*)(stg+row*64+ch*16); *(u32x4*)(Ow+(size_t)row*1024+ch*16)=v;} }
  qf=qn;
  asm volatile("s_waitcnt vmcnt(0) lgkmcnt(0)\n\ts_barrier":"+v"(qf)::"memory");
  #undef A8_DMA
  #undef A8_LP
  #undef A8_DMA_N
  #undef A8_KLOAD
  #undef A8_MFMA_P
  #undef A8_MPART
  #undef A8_MPART_S
  #undef A8_VPART
  #undef A8_CV
  #undef A8_PACK
  #undef A8_VLOAD
}
constexpr int ATTN_LDS_BYTES=LDS_BYTES;
#undef A8_WAIT_BAR
#undef A8_MFMA
}

constexpr int NWAVES = 8;
constexpr int BATCH = 8, SEQ = 4096, T = BATCH * SEQ, D = 1024, NE = 16, CAP = 512, FF = 2048, NQKV = 1536, MROWS = BATCH * NE * CAP;
constexpr float EPS = 1e-6f;
constexpr int N_PHASES = 17;
constexpr int N_LAUNCHES = MK_N_LAUNCHES;

constexpr size_t MiB = 1u << 20;
constexpr size_t WS_CTL = 0, CTL_ZERO_BYTES = 1 * MiB;
constexpr size_t WS_ROPE = 1 * MiB;
constexpr size_t WS_RS = 1 * MiB + 512 * 1024;
constexpr size_t WS_AFF = 2 * MiB;
constexpr size_t WS_IDX = 4 * MiB;
constexpr size_t WS_GATE = 4 * MiB + 512 * 1024;
constexpr size_t WS_INV = 5 * MiB;
constexpr size_t WS_WIN = 8 * MiB, WS_WOUT = 14 * MiB, WS_WQKV = 16 * MiB, WS_WO = 20 * MiB;
constexpr size_t WS_WGU = 32 * MiB;
constexpr size_t WS_WD = 288 * MiB;
constexpr size_t WS_XN = 416 * MiB;
constexpr size_t WS_BIG = 480 * MiB;
constexpr size_t WS_Y = 736 * MiB;
constexpr size_t WS_XN8 = 864 * MiB;
constexpr size_t WS_HB = 896 * MiB;
constexpr size_t WS_END = 960 * MiB;
constexpr int ESZ = MOE_FP8 ? 1 : 2;
constexpr float SC_W = 1024.f, SC_X = 16.f, SC_H = 8.f, SC_Y = 64.f;
constexpr int E8_W = 0x75757575, E8_X = 0x7B7B7B7B, E8_H = 0x7C7C7C7C;
constexpr float WG_FOLD = -1.4426950408889634f, WU_FOLD = -(SC_H / 8.f) / 1.4426950408889634f; constexpr int E8_WU = 0x78787878;
constexpr int CW_TMO = 0, CW_CODE = 1, CW_BAR = 4096, CW_CONV = 16384, CW_CONV2 = 16448;

constexpr int RING_OFF = 0, RING_BYTES = 131072;
constexpr int GIDX_OFF = RING_BYTES, GIDX_BYTES = 16384;
constexpr int LDSCTL_OFF = GIDX_OFF + GIDX_BYTES, MISC_OFF = LDSCTL_OFF + 320;
constexpr int LDS_BYTES = LDSCTL_OFF + 512;

#define GAS __attribute__((address_space(1)))
#define LAS __attribute__((address_space(3)))
typedef unsigned short bf16;
typedef unsigned v4u __attribute__((ext_vector_type(4)));
typedef unsigned v2u __attribute__((ext_vector_type(2)));
typedef float f32x4 __attribute__((ext_vector_type(4)));
typedef GAS unsigned gu32;
#define RLX_AGENT __ATOMIC_RELAXED, __HIP_MEMORY_SCOPE_AGENT
#define LDS_WAIT() asm volatile("s_waitcnt lgkmcnt(0)" ::: "memory")
#define VM_WAIT() asm volatile("s_waitcnt vmcnt(0)" ::: "memory")
__device__ __forceinline__ unsigned f2bf(float f) { unsigned u = __builtin_bit_cast(unsigned, f); return (u + 0x7fffu + ((u >> 16) & 1u)) >> 16; }
__device__ __forceinline__ unsigned pk2(float lo, float hi) { return f2bf(lo) | (f2bf(hi) << 16); }
__device__ __forceinline__ float bflo(unsigned w) { return __uint_as_float(w << 16); }
__device__ __forceinline__ float bfhi(unsigned w) { return __uint_as_float(w & 0xffff0000u); }

#define XB_TMO      128
#define XB_XCNT(j)  (256  + 64 * (j))
#define XB_XSUB(j)  (1280 + 64 * (j))
#define XB_XGEN(j)  (2304 + 64 * (j))
#define XB_TOP      3328
#define XB_TOPGEN   3392
#define XCD_BAR_WORDS 3456
#define XB_SPIN_CAP (1u << 18)

__device__ __forceinline__ unsigned xb_ld(unsigned* p)              { return __hip_atomic_load(p, __ATOMIC_RELAXED, __HIP_MEMORY_SCOPE_AGENT); }
__device__ __forceinline__ unsigned xb_add(unsigned* p, unsigned v) { return __hip_atomic_fetch_add(p, v, __ATOMIC_RELAXED, __HIP_MEMORY_SCOPE_AGENT); }
__device__ __forceinline__ unsigned xb_xcc_id() { return (unsigned)__builtin_amdgcn_s_getreg((3 << 11) | 20) & 0xFu; }
#define XB_SPIN(cond, bar) do { unsigned _sp = 0; while (cond) { __builtin_amdgcn_s_sleep(1); \
    if ((++_sp & 255u) == 0u) { if (xb_ld(&(bar)[XB_TMO])) break; if (_sp > XB_SPIN_CAP) { atomicAdd(&(bar)[XB_TMO], 1u); break; } } } } while (0)

struct XcdBarrier { unsigned* bar; unsigned x; volatile LAS unsigned* st; };
__device__ __forceinline__ XcdBarrier xcd_barrier_post(unsigned* bar, volatile LAS unsigned* st) {
    XcdBarrier b; b.bar = bar; b.x = xb_xcc_id(); b.st = st;
    if (threadIdx.x == 0) (void)xb_add(&bar[XB_XCNT(b.x)], 1u);
    return b;
}
__device__ __forceinline__ void xcd_barrier_complete(unsigned* bar, unsigned x, unsigned& nloc, unsigned& nx) {
    const unsigned G = gridDim.x * gridDim.y * gridDim.z;
    unsigned sum, cnt, mine, sp = 0u;
    for (;;) {
        sum = 0u; cnt = 0u; mine = 0u;
#pragma unroll
        for (unsigned j = 0; j < 16; ++j) { const unsigned c = xb_ld(&bar[XB_XCNT(j)]); sum += c; cnt += (c > 0u) ? 1u : 0u; mine = (j == x) ? c : mine; }
        if (sum == G) break;
        __builtin_amdgcn_s_sleep(1);
        if ((++sp & 255u) == 0u) { if (xb_ld(&bar[XB_TMO])) break; if (sp > XB_SPIN_CAP) { atomicAdd(&bar[XB_TMO], 1u); break; } }
    }
    nloc = mine > 0u ? mine : 1u; nx = cnt > 0u ? cnt : 1u;
}
__device__ __forceinline__ void xcd_barrier(const XcdBarrier& b) {
    asm volatile("s_waitcnt vmcnt(0)" ::: "memory");
    __syncthreads();
    if (threadIdx.x == 0) {
        unsigned* bar = b.bar;
        __builtin_amdgcn_s_waitcnt(0);
        unsigned nloc = b.st[0], nx = b.st[1];
        if (nloc == 0u) { xcd_barrier_complete(bar, b.x, nloc, nx); b.st[0] = nloc; b.st[1] = nx; }
        const unsigned old = xb_add(&bar[XB_XSUB(b.x)], 1u);
        const unsigned gen = old / nloc;
        if (old + 1u == (gen + 1u) * nloc) {
            __builtin_amdgcn_fence(__ATOMIC_RELEASE, "agent");
            asm volatile("s_waitcnt vmcnt(0)" ::: "memory");
            const unsigned og = xb_add(&bar[XB_TOP], 1u);
            const unsigned tg = og / nx;
            if (og + 1u == (tg + 1u) * nx) xb_add(&bar[XB_TOPGEN], 1u);
            else XB_SPIN(xb_ld(&bar[XB_TOPGEN]) == tg, bar);
            __builtin_amdgcn_fence(__ATOMIC_ACQUIRE, "agent");
            xb_add(&bar[XB_XGEN(b.x)], 1u);
            asm volatile("s_waitcnt vmcnt(0)" ::: "memory");
        } else {
            XB_SPIN(xb_ld(&bar[XB_XGEN(b.x)]) == gen, bar);
            __builtin_amdgcn_fence(__ATOMIC_ACQUIRE, "agent");
            asm volatile("s_waitcnt vmcnt(0)" ::: "memory");
        }
    }
    __syncthreads();
}

struct Frame {
    LAS unsigned char* lds;
    volatile LAS unsigned* MISC;
    gu32* ctl;
    int tid, lane, wave;
    int vcu, G;
};

__device__ __forceinline__ float wave_sum(float v) {
#pragma unroll
    for (int o = 1; o < 64; o <<= 1) v += __shfl_xor(v, o);
    return v;
}

template <int MAP> __device__ __forceinline__ int rowmap(int n) {
    if (MAP == 0) return n;
    if (MAP == 4) { if (n < 1024) return n; const int hsel = n >= 2048, ch = n - 1024 - 1024 * hsel; return 1024 + ((ch >> 7) << 8) + 128 * hsel + (ch & 127); }
    if (MAP == 2) return ((n >> 7) << 8) + (n & 127);
    if (MAP == 3) return ((n >> 7) << 8) + 128 + (n & 127);
    if (n < 1280) {
        const int h = n >> 6, d = n & 63, bj = d >> 5, dp = d & 31, nn = dp >> 4, fq = (dp & 15) >> 2, j = dp & 3, i = 8 * fq + 4 * nn + j;
        const int pn = (n < 1024) ? (h >> 2) : 4, wc = h & 3;
        return pn * 256 + bj * 128 + wc * 32 + i;
    }
    const int h = (n - 1280) >> 6, d = n & 63, bj = d >> 5, dp = d & 31;
    return 5 * 256 + bj * 128 + h * 32 + dp;
}
template <int MAP> __device__ __forceinline__ void tr_item(const float* __restrict__ W, int K, int N, bf16* __restrict__ WT, LAS float* scr, int kb, int nb, int lane, const float* kgain = nullptr) {
    const int k0 = 64 * kb, n0 = 64 * nb, c4 = lane & 15, rr = lane >> 4;
    f32x4 v[16];
#pragma unroll
    for (int i = 0; i < 16; ++i) v[i] = *(const GAS f32x4*)(W + (size_t)(k0 + 4 * i + rr) * N + n0 + 4 * c4);
    if (kgain) {
#pragma unroll
        for (int i = 0; i < 16; ++i) v[i] = v[i] * kgain[k0 + 4 * i + rr]; }
#pragma unroll
    for (int i = 0; i < 16; ++i) { LAS float* s = scr + (4 * i + rr) * 65 + 4 * c4; s[0] = v[i].x; s[1] = v[i].y; s[2] = v[i].z; s[3] = v[i].w; }
    LDS_WAIT(); asm volatile("" ::: "memory");
    const int c = lane & 7;
#pragma unroll
    for (int j = 0; j < 8; ++j) { const int nn = (lane >> 3) + 8 * j; const LAS float* s = scr + (8 * c) * 65 + nn;
        v4u o; o.x = pk2(s[0 * 65], s[1 * 65]); o.y = pk2(s[2 * 65], s[3 * 65]); o.z = pk2(s[4 * 65], s[5 * 65]); o.w = pk2(s[6 * 65], s[7 * 65]);
        *(GAS v4u*)(WT + (size_t)rowmap<MAP>(n0 + nn) * K + k0 + 8 * c) = o; }
    LDS_WAIT(); asm volatile("" ::: "memory");
}
template <int MAP> __device__ __forceinline__ void tr_item_f8(const float* __restrict__ W, int K, int N, unsigned char* __restrict__ WT, LAS float* scr, int kb, int nb, int lane, float sc) {
    const int k0 = 64 * kb, n0 = 64 * nb, c4 = lane & 15, rr = lane >> 4;
    f32x4 v[16];
#pragma unroll
    for (int i = 0; i < 16; ++i) v[i] = *(const GAS f32x4*)(W + (size_t)(k0 + 4 * i + rr) * N + n0 + 4 * c4);
#pragma unroll
    for (int i = 0; i < 16; ++i) { LAS float* s = scr + (4 * i + rr) * 65 + 4 * c4; s[0] = v[i].x; s[1] = v[i].y; s[2] = v[i].z; s[3] = v[i].w; }
    LDS_WAIT(); asm volatile("" ::: "memory");
    const int c = lane & 3;
#pragma unroll
    for (int j = 0; j < 4; ++j) { const int nn = (lane >> 2) + 16 * j; const LAS float* s = scr + (16 * c) * 65 + nn;
        v4u o; o.x = pg8::pk4_fp8(s[0 * 65] * sc, s[1 * 65] * sc, s[2 * 65] * sc, s[3 * 65] * sc); o.y = pg8::pk4_fp8(s[4 * 65] * sc, s[5 * 65] * sc, s[6 * 65] * sc, s[7 * 65] * sc);
        o.z = pg8::pk4_fp8(s[8 * 65] * sc, s[9 * 65] * sc, s[10 * 65] * sc, s[11 * 65] * sc); o.w = pg8::pk4_fp8(s[12 * 65] * sc, s[13 * 65] * sc, s[14 * 65] * sc, s[15 * 65] * sc);
        *(GAS v4u*)(WT + (size_t)rowmap<MAP>(n0 + nn) * K + k0 + 16 * c) = o; }
    LDS_WAIT(); asm volatile("" ::: "memory");
}
__device__ __forceinline__ float clamp448(float x) { return __builtin_fminf(__builtin_fmaxf(x, -448.f), 448.f); }
struct Tr8Item { const float* src; unsigned char* dst; int K, N, gu  , add, kb, nb; float sc; };
constexpr int TR8_PER_LAYER = 3 * 16 * 512;
__device__ __forceinline__ Tr8Item tr8_decode(int layer, int q_, const float* w_gate, const float* w_up, const float* w_down, unsigned char* WGU8, unsigned char* WD8) {
    Tr8Item t; const int which = q_ >> 13, mt = layer * 16 + ((q_ >> 9) & 15), q = q_ & 511, sub = q & 7, sup = q >> 3;
    if (which < 2) { const bool up = which == 1; t.src = (up ? w_up : w_gate) + (size_t)mt * 1024 * 2048; t.dst = WGU8 + (size_t)mt * 4096 * 1024; t.K = 1024; t.N = 2048; t.gu = 1; t.add = up ? 128 : 0; t.sc = SC_W * (up ? WU_FOLD : WG_FOLD);
        t.nb = 4 * (sup & 7) + (sub & 3); t.kb = 2 * (sup >> 3) + (sub >> 2); }
    else { t.src = w_down + (size_t)mt * 2048 * 1024; t.dst = WD8 + (size_t)mt * 1024 * 2048; t.K = 2048; t.N = 1024; t.gu = 0; t.add = 0; t.sc = SC_W; t.nb = 4 * (sup & 3) + (sub & 3); t.kb = 2 * (sup >> 2) + (sub >> 2); }
    return t;
}
__device__ __forceinline__ void tr8_load(const Tr8Item& t, int lane, f32x4 (&va)[8], f32x4 (&vb)[8]) {
    const int k0 = 64 * t.kb, n0 = 64 * t.nb, c4 = lane & 15, rr = lane >> 4;
#pragma unroll
    for (int i = 0; i < 8; ++i) { const float* p = t.src + (size_t)(k0 + 8 * i + 2 * rr) * t.N + n0 + 4 * c4; va[i] = *(const GAS f32x4*)p; vb[i] = *(const GAS f32x4*)(p + t.N); }
}
__device__ __forceinline__ void tr8_store(const Tr8Item& t, int lane, LAS unsigned char* scr) {
    constexpr int PITCH = 160;
    const int k0 = 64 * t.kb, n0 = 64 * t.nb;
    const int g = lane >> 4, i16 = lane & 15, q = i16 >> 2, pp = i16 & 3;
    typedef short v4i16_t __attribute__((ext_vector_type(4)));
#pragma unroll
    for (int s4 = 0; s4 < 4; ++s4) {
        const LAS unsigned char* a0 = scr + (8 * g + q) * PITCH + (16 * s4 + 4 * pp) * 2;
        const v4i16_t r0 = __builtin_amdgcn_ds_read_tr16_b64_v4i16((LAS v4i16_t*)a0), r1 = __builtin_amdgcn_ds_read_tr16_b64_v4i16((LAS v4i16_t*)(a0 + 4 * PITCH));
        const v2u lo = __builtin_bit_cast(v2u, r0), hi = __builtin_bit_cast(v2u, r1);
        v4u o; o.x = lo.x; o.y = lo.y; o.z = hi.x; o.w = hi.y;
        const int n = n0 + 16 * s4 + i16, row = t.gu ? (((n >> 7) << 8) + (n & 127) + t.add) : n;
        __builtin_nontemporal_store(o, (GAS v4u*)(t.dst + (size_t)row * t.K + k0 + 16 * g)); }
}
__device__ __forceinline__ void tr8_store_lean(const Tr8Item& t, int lane, LAS unsigned char* scr) {
    constexpr int PITCH = 160;
    const int k0 = 64 * t.kb, n0 = 64 * t.nb;
    const int g = lane >> 4, i16 = lane & 15, q = i16 >> 2, pp = i16 & 3;
    typedef short v4i16_t __attribute__((ext_vector_type(4)));
#pragma unroll 1
    for (int s4 = 0; s4 < 4; ++s4) {
        const LAS unsigned char* a0 = scr + (8 * g + q) * PITCH + (16 * s4 + 4 * pp) * 2;
        const v4i16_t r0 = __builtin_amdgcn_ds_read_tr16_b64_v4i16((LAS v4i16_t*)a0), r1 = __builtin_amdgcn_ds_read_tr16_b64_v4i16((LAS v4i16_t*)(a0 + 4 * PITCH));
        const v2u lo = __builtin_bit_cast(v2u, r0), hi = __builtin_bit_cast(v2u, r1);
        v4u o; o.x = lo.x; o.y = lo.y; o.z = hi.x; o.w = hi.y;
        const int n = n0 + 16 * s4 + i16, row = t.gu ? (((n >> 7) << 8) + (n & 127) + t.add) : n;
        __builtin_nontemporal_store(o, (GAS v4u*)(t.dst + (size_t)row * t.K + k0 + 16 * g));
        asm volatile("" ::: "memory"); }
}
__device__ __forceinline__ void tr8_finish(const Tr8Item& t, int lane, const f32x4 (&va)[8], const f32x4 (&vb)[8], LAS unsigned char* scr, float sc) {
    constexpr int PITCH = 160;
    const int k0 = 64 * t.kb, n0 = 64 * t.nb, c4 = lane & 15, rr = lane >> 4;
#pragma unroll
    for (int i = 0; i < 8; ++i) { const f32x4 a = va[i] * sc, b = vb[i] * sc; int w0 = 0, w1 = 0;
        w0 = __builtin_amdgcn_cvt_pk_fp8_f32(clamp448(a.x), clamp448(b.x), w0, false); w0 = __builtin_amdgcn_cvt_pk_fp8_f32(clamp448(a.y), clamp448(b.y), w0, true);
        w1 = __builtin_amdgcn_cvt_pk_fp8_f32(clamp448(a.z), clamp448(b.z), w1, false); w1 = __builtin_amdgcn_cvt_pk_fp8_f32(clamp448(a.w), clamp448(b.w), w1, true);
        v2u w; w.x = (unsigned)w0; w.y = (unsigned)w1; *(LAS v2u*)(scr + (4 * i + rr) * PITCH + 8 * c4) = w; }
    LDS_WAIT(); asm volatile("" ::: "memory");
    tr8_store(t, lane, scr);
    LDS_WAIT(); asm volatile("" ::: "memory");
}
__device__ __forceinline__ void rms_row_to_bf16(const float* xrow, const float* g, bf16* orow, int lane) {
    const GAS f32x4* xr = (const GAS f32x4*)xrow + lane; const GAS f32x4* gr = (const GAS f32x4*)g + lane;
    f32x4 v[4]; float s = 0.f;
#pragma unroll
    for (int j = 0; j < 4; ++j) { v[j] = xr[64 * j]; s += (v[j].x * v[j].x + v[j].y * v[j].y) + (v[j].z * v[j].z + v[j].w * v[j].w); }
    const float rs = 1.f / sqrtf(wave_sum(s) * (1.f / D) + EPS);
    GAS v2u* o8 = (GAS v2u*)orow + lane;
#pragma unroll
    for (int j = 0; j < 4; ++j) { const f32x4 gg = gr[64 * j]; v2u w; w.x = pk2(v[j].x * rs * gg.x, v[j].y * rs * gg.y); w.y = pk2(v[j].z * rs * gg.z, v[j].w * rs * gg.w); o8[64 * j] = w; }
}

struct Args { const float* in[15]; float* out; unsigned char* ws; int ph_lo, ph_hi; };

__device__ __forceinline__ void convert_layer(int layer, int first, int end, int gw, int NGW, int lane, LAS unsigned char* scr8, const float* w_gate, const float* w_up, const float* w_down, unsigned char* WGU8, unsigned char* WD8) {
    f32x4 a0[8], b0[8], a1[8], b1[8]; Tr8Item t0, t1;
    int r = first + gw;
    if (r < end) {
        t0 = tr8_decode(layer, r, w_gate, w_up, w_down, WGU8, WD8); tr8_load(t0, lane, a0, b0);
        for (;;) {
            int rn = r + NGW; bool hn = rn < end;
            if (hn) { t1 = tr8_decode(layer, rn, w_gate, w_up, w_down, WGU8, WD8); tr8_load(t1, lane, a1, b1); }
            tr8_finish(t0, lane, a0, b0, scr8, t0.sc);
            if (!hn) break;
            r = rn; rn = r + NGW; hn = rn < end;
            if (hn) { t0 = tr8_decode(layer, rn, w_gate, w_up, w_down, WGU8, WD8); tr8_load(t0, lane, a0, b0); }
            tr8_finish(t1, lane, a1, b1, scr8, t1.sc);
            if (!hn) break;
            r = rn;
        }
    }
}

__device__ __forceinline__ int conv_fetch(Frame& F, int cw) {
    if (F.tid == 0) F.MISC[16] = __hip_atomic_fetch_add((gu32*)(F.ctl + cw), 1u, RLX_AGENT);
    __syncthreads();
    const int v = (int)F.MISC[16];
    __syncthreads();
    return __builtin_amdgcn_readfirstlane(v);
}
__device__ __forceinline__ Tr8Item conv_item(int p, int wave, const float* w_gate, const float* w_up, const float* w_down, unsigned char* WGU8, unsigned char* WD8) {
    constexpr int PL = TR8_PER_LAYER / 8; const int layer = p >= PL ? 1 : 0;
    return tr8_decode(layer, (p - layer * PL) * 8 + wave, w_gate, w_up, w_down, WGU8, WD8);
}
__device__ __forceinline__ void convert_dynamic(Frame& F, int cw, int base, int NP, const float* w_gate, const float* w_up, const float* w_down, unsigned char* WGU8, unsigned char* WD8) {
    LAS unsigned char* scr8 = F.lds + F.wave * 18432;
    f32x4 a0[8], b0[8], a1[8], b1[8]; Tr8Item t0, t1;
    int p = conv_fetch(F, cw);
    if (p >= NP) return;
    t0 = conv_item(base + p, F.wave, w_gate, w_up, w_down, WGU8, WD8); tr8_load(t0, F.lane, a0, b0);
    for (;;) {
        p = conv_fetch(F, cw); bool hn = p < NP;
        if (hn) { t1 = conv_item(base + p, F.wave, w_gate, w_up, w_down, WGU8, WD8); tr8_load(t1, F.lane, a1, b1); }
        tr8_finish(t0, F.lane, a0, b0, scr8, t0.sc);
        if (!hn) break;
        p = conv_fetch(F, cw); hn = p < NP;
        if (hn) { t0 = conv_item(base + p, F.wave, w_gate, w_up, w_down, WGU8, WD8); tr8_load(t0, F.lane, a0, b0); }
        tr8_finish(t1, F.lane, a1, b1, scr8, t1.sc);
        if (!hn) break;
    }
}

struct SideConv {
    const float* w_gate; const float* w_up; const float* w_down; unsigned char* WGU8; unsigned char* WD8;
    LAS unsigned char* sb;
    int gw, NGW, total;
    int gi, gp, ib, pb, iP;
    const float* isrc; int ish;
    float psc;
    __device__ __forceinline__ void init(const float* g_, const float* u_, const float* d_, unsigned char* wgu, unsigned char* wd, LAS unsigned char* sb_, int gw_, int ngw_) {
        w_gate = g_; w_up = u_; w_down = d_; WGU8 = wgu; WD8 = wd; sb = sb_; gw = gw_; NGW = ngw_;
        total = gw_ < TR8_PER_LAYER ? ((TR8_PER_LAYER - 1 - gw_) / ngw_ + 1) * 16 : 0; gi = gp = ib = pb = iP = 0; isrc = g_; ish = 11; psc = 0.f; have = 0; ra = rb = (f32x2_){0.f, 0.f}; }
    __device__ __forceinline__ Tr8Item item(int g) const { return tr8_decode(1, gw + (g >> 4) * NGW, w_gate, w_up, w_down, WGU8, WD8); }
    typedef float f32x2_ __attribute__((ext_vector_type(2)));
    f32x2_ ra, rb; int have;
    __device__ __forceinline__ void preload(int lane_) {
        int lane = lane_; asm volatile("" : "+v"(lane));
        const LAS unsigned char* sl = sb + pb * 1024 + (lane >> 5) * 512 + (lane & 31) * 8;
        ra = *(const LAS f32x2_*)sl; rb = *(const LAS f32x2_*)(sl + 256);
        have = 1;
    }
    __device__ __forceinline__ void convert(int lane_) {
        int lane = lane_; asm volatile("" : "+v"(lane));
        const int i = gp & 15, p = lane >> 5, c2 = lane & 31;
        if (i == 0) { const int which = (gw + (gp >> 4) * NGW) >> 13; psc = SC_W * (which == 0 ? WG_FOLD : which == 1 ? WU_FOLD : 1.f); }
        const float sc = __int_as_float(__builtin_amdgcn_readfirstlane(__float_as_int(psc)));
        const f32x2_ a = ra * sc, b = rb * sc;
        int w = 0;
        w = __builtin_amdgcn_cvt_pk_fp8_f32(clamp448(a.x), clamp448(b.x), w, false); w = __builtin_amdgcn_cvt_pk_fp8_f32(clamp448(a.y), clamp448(b.y), w, true);
        *(LAS unsigned*)(sb + 3072 + (2 * i + p) * 160 + c2 * 4) = (unsigned)w;
        if (i == 15) { const Tr8Item t = item(gp); LDS_WAIT(); asm volatile("" ::: "memory"); tr8_store_lean(t, lane, sb + 3072); LDS_WAIT(); asm volatile("" ::: "memory"); }
        ++gp; pb = pb == 2 ? 0 : pb + 1; have = 0;
    }
    __device__ __forceinline__ void process(int lane) { preload(lane); convert(lane); }
    __device__ __forceinline__ void issue(int lane_) {
        int lane = lane_; asm volatile("" : "+v"(lane));
        if ((gi & 15) == 0) { const Tr8Item t = item(gi); isrc = t.src + (size_t)(64 * t.kb) * t.N + 64 * t.nb; ish = t.N == 2048 ? 11 : 10; }
        attn8::glds16(isrc + (((lane >> 4) << ish) + 4 * (lane & 15)), (unsigned)__builtin_amdgcn_readfirstlane((unsigned)(uintptr_t)sb + (unsigned)ib * 1024u));
        isrc += (size_t)4 << ish; ++gi; ib = ib == 2 ? 0 : ib + 1;
    }
    __device__ __forceinline__ void begin(int lane) { if (have) convert(lane); }
    __device__ __forceinline__ int end(int lane, bool allow) {
        if (gi - gp >= 3) preload(lane);
        if (allow && gi < total && gi - gp <= 2 + have) { issue(lane); const int c = iP ? 2 : 1; iP = 1; return c; }
        iP = 0; return 0;
    }
    __device__ __forceinline__ void flush(int lane) {
        if (have) convert(lane);
        while (gp < gi) process(lane);
        while (gi < total) { issue(lane); VM_WAIT(); process(lane); }
    }
};
struct SideNone { __device__ __forceinline__ void begin(int) {} __device__ __forceinline__ int end(int, bool) { return 0; } };

__device__ __forceinline__ void p0_prologue(Frame& F, const Args& a, unsigned char* ws) {
    LAS float* scr = (LAS float*)(F.lds + F.wave * 18432);
    const int gw = F.vcu * NWAVES + F.wave, NGW = F.G * NWAVES;
    const float* conv_in = a.in[3]; const float* conv_out = a.in[5]; const float* attn_qkv = a.in[6]; const float* attn_out = a.in[9];
    const float* w_gate = a.in[11]; const float* w_up = a.in[12]; const float* w_down = a.in[13];
    bf16* WIN = (bf16*)(ws + WS_WIN); bf16* WOUT = (bf16*)(ws + WS_WOUT); bf16* WQKV = (bf16*)(ws + WS_WQKV); bf16* WO = (bf16*)(ws + WS_WO);
    bf16* WGU = (bf16*)(ws + WS_WGU); bf16* WD = (bf16*)(ws + WS_WD);
    constexpr int I_IN = 16 * 48, I_OUT = 16 * 16, I_QKV = 16 * 24, I_O = 16 * 16, I_G = 32 * 512, I_D = 32 * 512;
    constexpr int NB16 = I_IN + I_OUT + I_QKV + I_O;
    for (int it = gw; it < NB16; it += NGW) {
        int r = it;
        if (r < I_IN) { tr_item<4>(conv_in, 1024, 3072, WIN, scr, r / 48, r % 48, F.lane, NORM_FOLD ? a.in[1] : nullptr); continue; } r -= I_IN;
        if (r < I_OUT) { tr_item<0>(conv_out, 1024, 1024, WOUT, scr, r / 16, r % 16, F.lane); continue; } r -= I_OUT;
#if ATTN_FP8
        if (r < I_QKV) { tr_item_f8<1>(attn_qkv, 1024, 1536, (unsigned char*)WQKV, scr, r / 24, r % 24, F.lane, SC_W); continue; } r -= I_QKV;
        tr_item_f8<0>(attn_out, 1024, 1024, (unsigned char*)WO, scr, r / 16, r % 16, F.lane, SC_W);
#else
        if (r < I_QKV) { tr_item<1>(attn_qkv, 1024, 1536, WQKV, scr, r / 24, r % 24, F.lane); continue; } r -= I_QKV;
        tr_item<0>(attn_out, 1024, 1024, WO, scr, r / 16, r % 16, F.lane);
#endif
    }
#if MOE_FP8
    if (P1_CONV > 0 && P1_ALL) { if (F.G <= P1_CONV) { convert_layer(0, 0, TR8_PER_LAYER, gw, NGW, F.lane, (LAS unsigned char*)scr, w_gate, w_up, w_down, (unsigned char*)(ws + WS_WGU), (unsigned char*)(ws + WS_WD)); convert_layer(1, 0, TR8_PER_LAYER, gw, NGW, F.lane, (LAS unsigned char*)scr, w_gate, w_up, w_down, (unsigned char*)(ws + WS_WGU), (unsigned char*)(ws + WS_WD)); } }
    else if (P1_CONV > 0 && ATTN_SIDE) convert_layer(0, F.G > P1_CONV ? P1_SPLIT : 0, TR8_PER_LAYER, gw, NGW, F.lane, (LAS unsigned char*)scr, w_gate, w_up, w_down, (unsigned char*)(ws + WS_WGU), (unsigned char*)(ws + WS_WD));
    else
    for (int rep_ = 0; rep_ < ((P0_REP & 2) ? 2 : 1); ++rep_)
    {
        unsigned char* WGU8 = (unsigned char*)(ws + WS_WGU); unsigned char* WD8 = (unsigned char*)(ws + WS_WD); LAS unsigned char* scr8 = (LAS unsigned char*)scr;
        constexpr int N8 = ATTN_SIDE ? TR8_PER_LAYER : 2 * TR8_PER_LAYER;
        f32x4 a0[8], b0[8], a1[8], b1[8]; Tr8Item t0, t1;
        int r = gw;
        if (r < N8) {
            t0 = tr8_decode(ATTN_SIDE ? 0 : r / TR8_PER_LAYER, ATTN_SIDE ? r : r % TR8_PER_LAYER, w_gate, w_up, w_down, WGU8, WD8); tr8_load(t0, F.lane, a0, b0);
            for (;;) {
                int rn = r + NGW; bool hn = rn < N8;
                if (hn) { t1 = tr8_decode(ATTN_SIDE ? 0 : rn / TR8_PER_LAYER, ATTN_SIDE ? rn : rn % TR8_PER_LAYER, w_gate, w_up, w_down, WGU8, WD8); tr8_load(t1, F.lane, a1, b1); }
                tr8_finish(t0, F.lane, a0, b0, scr8, t0.sc);
                if (!hn) break;
                r = rn; rn = r + NGW; hn = rn < N8;
                if (hn) { t0 = tr8_decode(ATTN_SIDE ? 0 : rn / TR8_PER_LAYER, ATTN_SIDE ? rn : rn % TR8_PER_LAYER, w_gate, w_up, w_down, WGU8, WD8); tr8_load(t0, F.lane, a0, b0); }
                tr8_finish(t1, F.lane, a1, b1, scr8, t1.sc);
                if (!hn) break;
                r = rn;
            }
        }
    }
#else
    for (int it = gw; it < 2 * I_G + I_D; it += NGW) {
        int r = it;
        if (r < I_G) { const int mt = r >> 9, q = r & 511; tr_item<2>(w_gate + (size_t)mt * 1024 * 2048, 1024, 2048, WGU + (size_t)mt * 4096 * 1024, scr, q >> 5, q & 31, F.lane); continue; } r -= I_G;
        if (r < I_G) { const int mt = r >> 9, q = r & 511; tr_item<3>(w_up + (size_t)mt * 1024 * 2048, 1024, 2048, WGU + (size_t)mt * 4096 * 1024, scr, q >> 5, q & 31, F.lane); continue; } r -= I_G;
        { const int mt = r >> 9, q = r & 511; tr_item<0>(w_down + (size_t)mt * 2048 * 1024, 2048, 1024, WD + (size_t)mt * 1024 * 2048, scr, q >> 4, q & 15, F.lane); }
    }
#endif
    { float* cosT = (float*)(ws + WS_ROPE); float* sinT = cosT + 1024;
      for (int i = blockIdx.x * 512 + F.tid; i < 1024; i += F.G * 512) { const int pos = i >> 4, fi = i & 15;
          const float inv = powf(10000.0f, -(float)(2 * fi) / 32.0f); const float ang = (float)pos * inv; cosT[i] = cosf(ang); sinT[i] = sinf(ang); } }
    for (int rep_ = 0; rep_ < ((P0_REP & 4) ? 2 : 1); ++rep_)
    { const float* x = a.in[0]; const float* g = a.in[1]; bf16* XN = (bf16*)(ws + WS_XN); const int lane = F.lane;
      f32x4 gv[4];
#pragma unroll
      for (int j = 0; j < 4; ++j) gv[j] = *(const GAS f32x4*)(g + 4 * lane + 256 * j);
      for (int m0 = gw * 4; m0 < T; m0 += NGW * 4) {
          f32x4 v[4][4];
#pragma unroll
          for (int r = 0; r < 4; ++r)
#pragma unroll
              for (int j = 0; j < 4; ++j) v[r][j] = *(const GAS f32x4*)(x + (size_t)(m0 + r) * D + 4 * lane + 256 * j);
#pragma unroll
          for (int r = 0; r < 4; ++r) { float ss = 0.f;
#pragma unroll
              for (int j = 0; j < 4; ++j) ss += (v[r][j].x * v[r][j].x + v[r][j].y * v[r][j].y) + (v[r][j].z * v[r][j].z + v[r][j].w * v[r][j].w);
              const float rs = 1.f / sqrtf(wave_sum(ss) * (1.f / D) + EPS);
              GAS v2u* o8 = (GAS v2u*)(XN + (size_t)(m0 + r) * D) + lane;
              if (NORM_FOLD && lane == 0) ((float*)(ws + WS_RS))[m0 + r] = rs;
#pragma unroll
              for (int j = 0; j < 4; ++j) { const f32x4 y = NORM_FOLD ? v[r][j] : v[r][j] * rs * gv[j]; v2u w; w.x = pk2(y.x, y.y); w.y = pk2(y.z, y.w); o8[64 * j] = w; } }
      } }
}

__device__ __forceinline__ void ld8(const bf16* p, float (&o)[8]) { const v4u w = *(const GAS v4u*)p; o[0] = bflo(w.x); o[1] = bfhi(w.x); o[2] = bflo(w.y); o[3] = bfhi(w.y); o[4] = bflo(w.z); o[5] = bfhi(w.z); o[6] = bflo(w.w); o[7] = bfhi(w.w); }
__device__ __forceinline__ void conv_phase(Frame& F, const bf16* BU, const float* cw, bf16* Z) {
    constexpr int R = 32;
    const int gw = F.vcu * NWAVES + F.wave, NGW = F.G * NWAVES;
    for (int item = gw; item < (T / R) * 2; item += NGW) {
        const int chunk = item >> 1, half = item & 1, t0 = chunk * R, ch = half * 512 + F.lane * 8, s0 = t0 & (SEQ - 1);
        float w0[8], w1[8], w2[8];
        { const f32x4 a0 = *(const GAS f32x4*)(cw + ch), a1 = *(const GAS f32x4*)(cw + ch + 4), b0 = *(const GAS f32x4*)(cw + 1024 + ch), b1 = *(const GAS f32x4*)(cw + 1024 + ch + 4), c0 = *(const GAS f32x4*)(cw + 2048 + ch), c1 = *(const GAS f32x4*)(cw + 2048 + ch + 4);
#pragma unroll
          for (int q = 0; q < 4; ++q) { w0[q] = a0[q]; w0[4 + q] = a1[q]; w1[q] = b0[q]; w1[4 + q] = b1[q]; w2[q] = c0[q]; w2[4 + q] = c1[q]; } }
        const bf16* pb = BU + (size_t)t0 * 2048 + ch; const bf16* pu = pb + 1024;
        float up[8], uc[8], un[8];
        if (s0 > 0) ld8(pu - 2048, up);
        else {
#pragma unroll
            for (int q = 0; q < 8; ++q) up[q] = 0.f; }
        ld8(pu, uc);
#pragma unroll 8
        for (int i = 0; i < R; ++i) {
            if (s0 + i + 1 < SEQ) ld8(pu + (size_t)(i + 1) * 2048, un);
            else {
#pragma unroll
                for (int q = 0; q < 8; ++q) un[q] = 0.f; }
            float bv[8]; ld8(pb + (size_t)i * 2048, bv);
            float z[8];
#pragma unroll
            for (int q = 0; q < 8; ++q) z[q] = bv[q] * (w0[q] * up[q] + w1[q] * uc[q] + w2[q] * un[q]);
            v4u o; o.x = pk2(z[0], z[1]); o.y = pk2(z[2], z[3]); o.z = pk2(z[4], z[5]); o.w = pk2(z[6], z[7]);
            __builtin_nontemporal_store(o, (GAS v4u*)(Z + (size_t)(t0 + i) * 1024 + ch));
#pragma unroll
            for (int q = 0; q < 8; ++q) { up[q] = uc[q]; uc[q] = un[q]; }
        }
    }
}

__device__ __forceinline__ void router_phase(Frame& F, const bf16* H, const float* gain, const float* wrt  , bf16* XN, float* AFF) {
    LAS float* wl = (LAS float*)(F.lds + RING_OFF);
    const int gw = F.vcu * NWAVES + F.wave, NGW = F.G * NWAVES, lane = F.lane;
    v2u xr[4][4];
    if (gw * 4 < T) {
#pragma unroll
        for (int r = 0; r < 4; ++r)
#pragma unroll
            for (int j = 0; j < 4; ++j) xr[r][j] = *(const GAS v2u*)(H + (size_t)(gw * 4 + r) * D + 4 * lane + 256 * j); }
    f32x4 gv[4];
#pragma unroll
    for (int j = 0; j < 4; ++j) gv[j] = *(const GAS f32x4*)(gain + 4 * lane + 256 * j);
    for (int i = F.tid; i < 4096; i += NWAVES * 64) { const int k = i >> 2, e4 = i & 3; const f32x4 v = *(const GAS f32x4*)(wrt + k * 16 + 4 * e4);
        wl[(4 * e4 + 0) * 1024 + k] = v.x; wl[(4 * e4 + 1) * 1024 + k] = v.y; wl[(4 * e4 + 2) * 1024 + k] = v.z; wl[(4 * e4 + 3) * 1024 + k] = v.w; }
    __syncthreads();
    typedef float f32x2 __attribute__((ext_vector_type(2)));
    for (int m0 = gw * 4; m0 < T; m0 += NGW * 4) {
        f32x2 xp[2][4][4];
#pragma unroll
        for (int rp = 0; rp < 2; ++rp)
#pragma unroll
            for (int j = 0; j < 4; ++j) { const v2u w0 = xr[2 * rp][j], w1 = xr[2 * rp + 1][j];
                xp[rp][j][0] = (f32x2){bflo(w0.x), bflo(w1.x)}; xp[rp][j][1] = (f32x2){bfhi(w0.x), bfhi(w1.x)}; xp[rp][j][2] = (f32x2){bflo(w0.y), bflo(w1.y)}; xp[rp][j][3] = (f32x2){bfhi(w0.y), bfhi(w1.y)}; }
        { const int m1 = m0 + NGW * 4;
          if (m1 < T) {
#pragma unroll
            for (int r = 0; r < 4; ++r)
#pragma unroll
                for (int j = 0; j < 4; ++j) xr[r][j] = *(const GAS v2u*)(H + (size_t)(m1 + r) * D + 4 * lane + 256 * j); } }
#pragma unroll
        for (int rp = 0; rp < 2; ++rp) {
            f32x2 s2 = (f32x2){0.f, 0.f};
#pragma unroll
            for (int j = 0; j < 4; ++j)
#pragma unroll
                for (int c = 0; c < 4; ++c) s2 += xp[rp][j][c] * xp[rp][j][c];
            const f32x2 rs2 = (f32x2){1.f / sqrtf(wave_sum(s2.x) * (1.f / D) + EPS), 1.f / sqrtf(wave_sum(s2.y) * (1.f / D) + EPS)};
#pragma unroll
            for (int j = 0; j < 4; ++j)
#pragma unroll
                for (int c = 0; c < 4; ++c) xp[rp][j][c] = xp[rp][j][c] * rs2 * gv[j][c];
#if MOE_FP8
#pragma unroll
            for (int h = 0; h < 2; ++h) { GAS unsigned* o4 = (GAS unsigned*)((unsigned char*)XN + (size_t)(m0 + 2 * rp + h) * D) + lane;
#pragma unroll
                for (int j = 0; j < 4; ++j) o4[64 * j] = pg8::pk4_fp8(xp[rp][j][0][h] * SC_X, xp[rp][j][1][h] * SC_X, xp[rp][j][2][h] * SC_X, xp[rp][j][3][h] * SC_X); }
#else
#pragma unroll
            for (int h = 0; h < 2; ++h) { GAS v2u* o8 = (GAS v2u*)(XN + (size_t)(m0 + 2 * rp + h) * D) + lane;
#pragma unroll
                for (int j = 0; j < 4; ++j) { v2u w; w.x = pk2(xp[rp][j][0][h], xp[rp][j][1][h]); w.y = pk2(xp[rp][j][2][h], xp[rp][j][3][h]); o8[64 * j] = w; } }
#endif
        }
        f32x2 a2[2][16];
#pragma unroll
        for (int rp = 0; rp < 2; ++rp)
#pragma unroll
            for (int e = 0; e < 16; ++e) a2[rp][e] = (f32x2){0.f, 0.f};
#pragma unroll
        for (int e = 0; e < 16; ++e)
#pragma unroll
            for (int j = 0; j < 4; ++j) { const f32x4 wv = *(const LAS f32x4*)(wl + e * 1024 + 256 * j + 4 * lane);
#pragma unroll
                for (int rp = 0; rp < 2; ++rp) { a2[rp][e] += xp[rp][j][0] * wv.x; a2[rp][e] += xp[rp][j][1] * wv.y; a2[rp][e] += xp[rp][j][2] * wv.z; a2[rp][e] += xp[rp][j][3] * wv.w; }
                if (j == 3 && (e & 1)) asm volatile("" ::: "memory"); }
        float a[64];
#pragma unroll
        for (int r = 0; r < 4; ++r)
#pragma unroll
            for (int e = 0; e < 16; ++e) a[r * 16 + e] = a2[r >> 1][e][r & 1];
#pragma unroll
        for (int i = 0; i < 32; ++i) { const bool up = (lane & 32) != 0; const float keep = up ? a[i + 32] : a[i], send = up ? a[i] : a[i + 32]; a[i] = keep + __shfl_xor(send, 32); }
#pragma unroll
        for (int i = 0; i < 16; ++i) { const bool up = (lane & 16) != 0; const float keep = up ? a[i + 16] : a[i], send = up ? a[i] : a[i + 16]; a[i] = keep + __shfl_xor(send, 16); }
#pragma unroll
        for (int i = 0; i < 8; ++i) { const bool up = (lane & 8) != 0; const float keep = up ? a[i + 8] : a[i], send = up ? a[i] : a[i + 8]; a[i] = keep + __shfl_xor(send, 8); }
#pragma unroll
        for (int i = 0; i < 4; ++i) { const bool up = (lane & 4) != 0; const float keep = up ? a[i + 4] : a[i], send = up ? a[i] : a[i + 4]; a[i] = keep + __shfl_xor(send, 4); }
#pragma unroll
        for (int i = 0; i < 2; ++i) { const bool up = (lane & 2) != 0; const float keep = up ? a[i + 2] : a[i], send = up ? a[i] : a[i + 2]; a[i] = keep + __shfl_xor(send, 2); }
        { const bool up = (lane & 1) != 0; const float keep = up ? a[1] : a[0], send = up ? a[0] : a[1]; a[0] = keep + __shfl_xor(send, 1); }
        const float logit = a[0];
        float mx = logit;
#pragma unroll
        for (int o = 1; o < 16; o <<= 1) mx = fmaxf(mx, __shfl_xor(mx, o));
        const float p = expf(logit - mx); float sm = p;
#pragma unroll
        for (int o = 1; o < 16; o <<= 1) sm += __shfl_xor(sm, o);
        const int row = m0 + (lane >> 4), e = lane & 15, b = row >> 12, t = row & (SEQ - 1);
        AFF[((size_t)(b * 16 + e) << 12) + t] = p / sm;
    }
}

__device__ __forceinline__ void topk_phase(Frame& F, const float* AFF, int* IDX, float* GATE, int* INV) {
    LAS unsigned* hist = (LAS unsigned*)(F.lds + RING_OFF); LAS unsigned* sel = hist + 256; LAS unsigned* wtot = hist + 272;
    const int tid = F.tid, lane = F.lane, wave = F.wave;
    for (int job = blockIdx.x; job < BATCH * NE; job += F.G) {
        const int b = job >> 4, e = job & 15;
        const float* src = AFF + (size_t)job * SEQ + tid * 8;
        const f32x4 v0 = *(const GAS f32x4*)src, v1 = *(const GAS f32x4*)(src + 4);
        float av[8] = {v0.x, v0.y, v0.z, v0.w, v1.x, v1.y, v1.z, v1.w}; unsigned key[8];
#pragma unroll
        for (int i = 0; i < 8; ++i) key[i] = __float_as_uint(av[i]);
        unsigned prefix = 0u, mask = 0u, remaining = CAP;
#pragma unroll 1
        for (int pass = 0; pass < 4; ++pass) {
            const int shift = 24 - 8 * pass;
            if (tid < 256) hist[tid] = 0u;
            __syncthreads();
#pragma unroll
            for (int i = 0; i < 8; ++i) if ((key[i] & mask) == prefix) __hip_atomic_fetch_add(hist + ((key[i] >> shift) & 255u), 1u, __ATOMIC_RELAXED, __HIP_MEMORY_SCOPE_WORKGROUP);
            __syncthreads();
            if (wave == 0) {
                const unsigned h0 = hist[4 * lane], h1 = hist[4 * lane + 1], h2 = hist[4 * lane + 2], h3 = hist[4 * lane + 3];
                const unsigned c = h0 + h1 + h2 + h3;
                unsigned S = c;
#pragma unroll
                for (int o = 1; o < 64; o <<= 1) { const unsigned tt = __shfl_down(S, o); if (lane + o < 64) S += tt; }
                const unsigned Sn = S - c;
                if (Sn < remaining && remaining <= S) {
                    unsigned rem = remaining - Sn; int d;
                    if (h3 >= rem) d = 3; else { rem -= h3; if (h2 >= rem) d = 2; else { rem -= h2; if (h1 >= rem) d = 1; else { rem -= h1; d = 0; } } }
                    sel[0] = prefix | ((unsigned)(4 * lane + d) << shift); sel[1] = rem;
                }
            }
            __syncthreads();
            prefix = sel[0]; remaining = sel[1]; mask |= 0xFFu << shift;
        }
        const unsigned Tk = prefix;
        unsigned cg = 0u, ce = 0u;
#pragma unroll
        for (int i = 0; i < 8; ++i) { cg += key[i] > Tk ? 1u : 0u; ce += key[i] == Tk ? 1u : 0u; }
        const unsigned pk = cg | (ce << 16);
        unsigned inc = pk;
#pragma unroll
        for (int o = 1; o < 64; o <<= 1) { const unsigned tt = __shfl_up(inc, o); if (lane >= o) inc += tt; }
        if (lane == 63) wtot[wave] = inc;
        __syncthreads();
        unsigned base = 0u;
        for (int w = 0; w < wave; ++w) base += wtot[w];
        const unsigned excl = base + inc - pk;
        unsigned gt_before = excl & 0xFFFFu, eq_before = excl >> 16;
#pragma unroll
        for (int i = 0; i < 8; ++i) {
            const int t = tid * 8 + i; const unsigned k = key[i]; int slot = -1;
            if (k > Tk) { slot = (int)(gt_before + (eq_before < remaining ? eq_before : remaining)); ++gt_before; }
            else if (k == Tk) { if (eq_before < remaining) slot = (int)(gt_before + eq_before); ++eq_before; }
            INV[((size_t)(b * SEQ + t) << 4) + e] = slot;
            if (slot >= 0) { const int m = ((e * BATCH + b) << 9) + slot; IDX[m] = b * SEQ + t; GATE[m] = av[i]; }
        }
        __syncthreads();
    }
}

__device__ __forceinline__ void combine_phase(Frame& F, bf16* H, const unsigned char* Y, const int* INV, const float* gain, bf16* XN, float* OUT, bool fin, bool xn8 = false) {
    constexpr int RP = 8;
    const int gw = F.vcu * NWAVES + F.wave, NGW = F.G * NWAVES, lane = F.lane;
    typedef float f32x2 __attribute__((ext_vector_type(2)));
    f32x4 gv[2][2];
#pragma unroll
    for (int j = 0; j < 2; ++j) { gv[j][0] = *(const GAS f32x4*)(gain + 512 * j + 8 * lane); gv[j][1] = *(const GAS f32x4*)(gain + 512 * j + 8 * lane + 4); }
    for (int m0 = gw * RP; m0 < T; m0 += NGW * RP) {
        int inv[RP / 4];
#pragma unroll
        for (int q = 0; q < RP / 4; ++q) inv[q] = INV[((size_t)(m0 + 4 * q + (lane >> 4)) << 4) + (lane & 15)];
        f32x4 v[RP][2][2];
#pragma unroll
        for (int r = 0; r < RP; ++r)
#pragma unroll
            for (int j = 0; j < 2; ++j) { const v4u w = *(const GAS v4u*)(H + (size_t)(m0 + r) * D + 512 * j + 8 * lane);
                v[r][j][0] = (f32x4){bflo(w.x), bfhi(w.x), bflo(w.y), bfhi(w.y)}; v[r][j][1] = (f32x4){bflo(w.z), bfhi(w.z), bflo(w.w), bfhi(w.w)}; }
        unsigned mk[RP];
#pragma unroll
        for (int q = 0; q < RP / 4; ++q) { const unsigned long long vm = __ballot(inv[q] >= 0);
#pragma unroll
            for (int r = 0; r < 4; ++r) mk[4 * q + r] = (unsigned)(vm >> (16 * r)) & 0xFFFFu; }
        unsigned any = 0u;
#pragma unroll
        for (int r = 0; r < RP; ++r) any |= mk[r];
        while (any) {
            v2u y[RP][2]; bool has[RP];
#pragma unroll
            for (int r = 0; r < RP; ++r) {
                has[r] = mk[r] != 0u;
                if (has[r]) { const int e = __builtin_ctz(mk[r]); mk[r] &= mk[r] - 1u;
                    const int slot = __shfl(inv[r >> 2], (r & 3) * 16 + e); const int b = (m0 + r) >> 12;
                    const unsigned char* yp = Y + ((size_t)(((e * BATCH + b) << 9) + slot) << 10) + 8 * lane;
                    y[r][0] = *(const GAS v2u*)yp; y[r][1] = *(const GAS v2u*)(yp + 512); }
            }
            any = 0u;
#pragma unroll
            for (int r = 0; r < RP; ++r) { any |= mk[r]; if (has[r]) {
#pragma unroll
                for (int j = 0; j < 2; ++j) { const v2u w = y[r][j];
                    const f32x2 a = __builtin_amdgcn_cvt_pk_f32_fp8((int)w.x, false), b2 = __builtin_amdgcn_cvt_pk_f32_fp8((int)w.x, true), c = __builtin_amdgcn_cvt_pk_f32_fp8((int)w.y, false), d = __builtin_amdgcn_cvt_pk_f32_fp8((int)w.y, true);
                    v[r][j][0] += (f32x4){a.x, a.y, b2.x, b2.y} * (1.0f / SC_Y); v[r][j][1] += (f32x4){c.x, c.y, d.x, d.y} * (1.0f / SC_Y); }
            } }
        }
#pragma unroll
        for (int r = 0; r < RP; ++r) {
            float ss = 0.f;
#pragma unroll
            for (int j = 0; j < 2; ++j)
#pragma unroll
                for (int q = 0; q < 2; ++q) { const f32x4 x = v[r][j][q]; ss += (x.x * x.x + x.y * x.y) + (x.z * x.z + x.w * x.w); }
            const float rs = 1.f / sqrtf(wave_sum(ss) * (1.f / D) + EPS);
            if (!fin) {
#pragma unroll
                for (int j = 0; j < 2; ++j) { const f32x4 h0 = v[r][j][0], h1 = v[r][j][1];
                    v4u hw; hw.x = pk2(h0.x, h0.y); hw.y = pk2(h0.z, h0.w); hw.z = pk2(h1.x, h1.y); hw.w = pk2(h1.z, h1.w);
                    *(GAS v4u*)(H + (size_t)(m0 + r) * D + 512 * j + 8 * lane) = hw;
                    const f32x4 a0 = h0 * rs * gv[j][0], a1 = h1 * rs * gv[j][1];
                    if (xn8) { v2u w; const f32x4 b0_ = a0 * SC_X, b1_ = a1 * SC_X; w.x = pg8::pk4_fp8(b0_.x, b0_.y, b0_.z, b0_.w); w.y = pg8::pk4_fp8(b1_.x, b1_.y, b1_.z, b1_.w);
                        *(GAS v2u*)((unsigned char*)XN + (size_t)(m0 + r) * D + 512 * j + 8 * lane) = w; }
                    else { v4u w; w.x = pk2(a0.x, a0.y); w.y = pk2(a0.z, a0.w); w.z = pk2(a1.x, a1.y); w.w = pk2(a1.z, a1.w);
                        *(GAS v4u*)(XN + (size_t)(m0 + r) * D + 512 * j + 8 * lane) = w; } }
            } else {
#pragma unroll
                for (int j = 0; j < 2; ++j) { float* op = OUT + (size_t)(m0 + r) * D + 512 * j + 8 * lane; *(GAS f32x4*)op = v[r][j][0] * rs * gv[j][0]; *(GAS f32x4*)(op + 4) = v[r][j][1] * rs * gv[j][1]; }
            }
        }
    }
}

__device__ __forceinline__ void nan_rows_f32(Frame& F, float* out) {
    const int gw = F.vcu * NWAVES + F.wave, NGW = F.G * NWAVES; const float q = __builtin_nanf("");
    for (int m = gw; m < T; m += NGW) { GAS f32x4* o = (GAS f32x4*)(out + (size_t)m * D) + F.lane;
#pragma unroll
        for (int j = 0; j < 4; ++j) o[64 * j] = (f32x4){q, q, q, q}; }
}

#define MOE_BLOCK(layer, pb) do { \
    RUNPHASE((pb), router_phase(F, H, args.in[2] + layer * D, args.in[10] + (size_t)layer * D * NE, MOE_FP8 ? (bf16*)(ws + WS_XN8) : XN, AFF)); \
    SEAM(pb); \
    RUNPHASE((pb) + 1, topk_phase(F, AFF, IDX, GATE, INV)); \
    SEAM(pb + 1); \
    RUNPHASE((pb) + 2, { \
        pg8::Moe1Order S{F.G, F.vcu}; \
        LAS unsigned* gi = (LAS unsigned*)(F.lds + GIDX_OFF); \
        for (int i = 0; i < 16; ++i) { pg8::Unit u; if (!S.next(i, u)) break; \
            if (F.tid < 256) gi[i * 256 + F.tid] = (unsigned)IDX[u.pm * 256 + F.tid] * (unsigned)(D * ESZ); } \
        VM_WAIT(); LDS_WAIT(); __syncthreads(); \
        pg8::Gemm g{MOE_FP8 ? (const void*)(ws + WS_XN8) : (const void*)XN, ws + WS_WGU + (size_t)layer * NE * 4096 * 1024 * ESZ, D, gi, E8_X, E8_W, E8_WU}; \
        pg8::EpiSwiGLU<MOE_FP8 != 0> E{HMID, FF, SC_H}; \
        pg8::gemm_phase<pg8::EpiSwiGLU<MOE_FP8 != 0>, pg8::Moe1Order, true, MOE_FP8 != 0, KREP_MOE1>(F.lds + RING_OFF, g, S, E); \
    }); \
    SEAM(pb + 2); \
    RUNPHASE((pb) + 3, { \
        pg8::Moe2Order S{F.G, F.vcu}; \
        pg8::Gemm g{HMID, ws + WS_WD + (size_t)layer * NE * 1024 * 2048 * ESZ, FF, nullptr, E8_H, E8_W, E8_W}; \
        LAS float* gs = (LAS float*)(F.lds + GIDX_OFF);                       \
        for (int i = 0; i < 4; ++i) { pg8::Unit u; if (!S.next(i, u)) break; if (F.tid < 256) gs[i * 256 + F.tid] = GATE[u.pm * 256 + F.tid] * SC_Y; } \
        VM_WAIT(); LDS_WAIT(); __syncthreads(); \
        pg8::EpiScaleF8 E{Y, D, gs}; \
        pg8::gemm_phase<pg8::EpiScaleF8, pg8::Moe2Order, false, MOE_FP8 != 0>(F.lds + RING_OFF, g, S, E); \
    }); \
    SEAM(pb + 3); \
    RUNPHASE((pb) + 4, { \
        if (layer == 0) combine_phase(F, H, Y, INV, args.in[1] + D, ATTN_FP8 ? (bf16*)(ws + WS_XN8) : XN, nullptr, false, ATTN_FP8 != 0); \
        else { \
            const bool bad = __hip_atomic_load((gu32*)((unsigned*)(F.ctl + CW_BAR) + XB_TMO), RLX_AGENT) != 0u; \
            if (bad) nan_rows_f32(F, args.out); else combine_phase(F, H, Y, INV, args.in[14], nullptr, args.out, true); \
        } \
    }); \
    if (layer == 0) SEAM(pb + 4); \
    } while (0)
__global__ void __launch_bounds__(NWAVES * 64, 2) skel_fwd(Args args) {
    extern __shared__ __attribute__((aligned(1024))) unsigned char lds[];
    Frame F;
    F.lds = (LAS unsigned char*)lds;
    F.MISC = (volatile LAS unsigned*)(F.lds + MISC_OFF);
    F.tid = threadIdx.x; F.lane = F.tid & 63; F.wave = __builtin_amdgcn_readfirstlane(F.tid >> 6);
    F.G = gridDim.x; { const int bx = blockIdx.x; F.vcu = (F.G % 8 == 0) ? (bx % 8) * (F.G / 8) + bx / 8 : bx; }
    unsigned char* ws = args.ws;
    F.ctl = (gu32*)(ws + WS_CTL);
    for (int u = F.tid; u < (LDS_BYTES - LDSCTL_OFF) / 4; u += NWAVES * 64) ((LAS unsigned*)(F.lds + LDSCTL_OFF))[u] = 0u;
    __syncthreads();
    const int lo = args.ph_lo, hi = args.ph_hi;
    const bool use_bar = (hi - lo) > 1;
    XcdBarrier bar; bar.bar = (unsigned*)(F.ctl + CW_BAR); bar.x = 0; bar.st = nullptr;
    if (use_bar) bar = xcd_barrier_post((unsigned*)(F.ctl + CW_BAR), F.MISC + 8);
#ifndef PHASE_MASK
#define PHASE_MASK 0xFFFFF
#endif
#define EN(k) (((PHASE_MASK) >> (k)) & 1)
#define IN(k) (lo <= (k) && (k) < hi)
#ifndef REP_PHASE
#define REP_PHASE (-1)
#endif
#define RUNPHASE(k, ...) do { if (EN(k) && IN(k)) { __VA_ARGS__; if ((k) == REP_PHASE) { xcd_barrier(bar); __VA_ARGS__; } } } while (0)
#define SEAM(k) do { if (IN(k) && IN((k) + 1)) xcd_barrier(bar); } while (0)

    bf16* H = (bf16*)(ws + WS_HB);
    bf16* XN = (bf16*)(ws + WS_XN);
    bf16* BU = (bf16*)(ws + WS_BIG); bf16* Z = (bf16*)(ws + WS_BIG + 192 * MiB);
    bf16* QB_ = (bf16*)(ws + WS_BIG); bf16* KB_ = (bf16*)(ws + WS_BIG + 64 * MiB); bf16* VB_ = (bf16*)(ws + WS_BIG + 80 * MiB); bf16* OB_ = (bf16*)(ws + WS_BIG + 96 * MiB);
    bf16* HMID = (bf16*)(ws + WS_BIG); unsigned char* Y = (unsigned char*)(ws + WS_Y);
    float* AFF = (float*)(ws + WS_AFF); int* IDX = (int*)(ws + WS_IDX); float* GATE = (float*)(ws + WS_GATE); int* INV = (int*)(ws + WS_INV);
    const float* cosT = (const float*)(ws + WS_ROPE); const float* sinT = cosT + 1024;

    RUNPHASE(0, p0_prologue(F, args, ws));
    SEAM(0);
    RUNPHASE(1, {
        const int NC = (P1_CONV > 0 && (ATTN_SIDE || P1_ALL) && F.G > P1_CONV) ? F.G - P1_CONV : F.G;
        if ((int)blockIdx.x < NC) {
            pg8::Gemm g{XN, (const bf16*)(ws + WS_WIN), D, nullptr, 0, 0, 0}; pg8::StaticOrder S; S.init(T, 3 * D, NC, (int)blockIdx.x);
            LAS float* rt_ = (LAS float*)(F.lds + GIDX_OFF);
            if (NORM_FOLD) { for (int i = 0; i < 16; ++i) { pg8::Unit u; if (!S.next(i, u)) break; if (F.tid < 256) rt_[i * 256 + F.tid] = ((const float*)(ws + WS_RS))[u.pm * 256 + F.tid]; }
                VM_WAIT(); LDS_WAIT(); __syncthreads(); }
            pg8::EpiConvIn E{BU, NORM_FOLD ? rt_ : nullptr};
            pg8::gemm_phase<pg8::EpiConvIn, pg8::StaticOrder, false, false, KREP_P1>(F.lds + RING_OFF, g, S, E);
        }
        if (P1_ALL && NC < F.G) convert_dynamic(F, CW_CONV, 0, 2 * TR8_PER_LAYER / 8 - (F.G == 256 ? P10_PANELS : 0), args.in[11], args.in[12], args.in[13], (unsigned char*)(ws + WS_WGU), (unsigned char*)(ws + WS_WD));
    });
    SEAM(1);
    RUNPHASE(2, conv_phase(F, BU, args.in[4], Z));
    SEAM(2);
    RUNPHASE(3, {
        pg8::Gemm g{Z, (const bf16*)(ws + WS_WOUT), D, nullptr, 0, 0, 0}; pg8::StaticOrder S; S.init(T, D, F.G, (int)blockIdx.x);
#if NORM_FOLD
        pg8::EpiBf16Res<false> E{XN, H, D};
        pg8::gemm_phase<pg8::EpiBf16Res<false>, pg8::StaticOrder, false>(F.lds + RING_OFF, g, S, E);
#else
        pg8::EpiBf16Res<true> E{args.in[0], H, D};
        pg8::gemm_phase<pg8::EpiBf16Res<true>, pg8::StaticOrder, false>(F.lds + RING_OFF, g, S, E);
#endif
    });
    SEAM(3);
    MOE_BLOCK(0, 4);
#if ATTN_FP8
    RUNPHASE(9, {
        pg8::Gemm g{ws + WS_XN8, ws + WS_WQKV, D, nullptr, E8_X, E8_W, E8_W}; pg8::StaticOrder S; S.init(T, NQKV, F.G, (int)blockIdx.x);
        LAS float* tb = (LAS float*)(F.lds + GIDX_OFF);
        for (int i = F.tid; i < 2048; i += NWAVES * 64) tb[i] = cosT[i];
        if (F.tid < 64) { tb[2048 + F.tid] = args.in[7][F.tid]; tb[2112 + F.tid] = args.in[8][F.tid]; }
        VM_WAIT(); LDS_WAIT(); __syncthreads();
        pg8::EpiQKV8 E{(unsigned char*)QB_, (unsigned char*)KB_, (unsigned char*)VB_, tb, attn8::SQ, attn8::SK, attn8::SV};
        pg8::gemm_phase<pg8::EpiQKV8, pg8::StaticOrder, false, true>(F.lds + RING_OFF, g, S, E);
    });
#else
    RUNPHASE(9, {
        pg8::Gemm g{XN, (const bf16*)(ws + WS_WQKV), D, nullptr, 0, 0, 0}; pg8::StaticOrder S; S.init(T, NQKV, F.G, (int)blockIdx.x);
        pg8::EpiQKV E{QB_, KB_, VB_, args.in[7], args.in[8], cosT, sinT, attn_body::C2};
        pg8::gemm_phase<pg8::EpiQKV, pg8::StaticOrder, false>(F.lds + RING_OFF, g, S, E);
    });
#endif
    SEAM(9);
    RUNPHASE(10, {
#if ATTN_FP8
        float att_sc;
        { float gq = fabsf(args.in[7][F.lane]), gk = fabsf(args.in[8][F.lane]);
          _Pragma("unroll") for (int o_ = 1; o_ < 64; o_ <<= 1) { gq = fmaxf(gq, __shfl_xor(gq, o_)); gk = fmaxf(gk, __shfl_xor(gk, o_)); }
          const float bnd = 1.13f * 64.f * attn_body::C2 * gq * gk; att_sc = exp2f(fmaxf(0.f, ceilf(bnd) - 15.f)); }
#endif
#if ATTN_FP8
        { attn8::i32x8 qcarry = (attn8::i32x8){0, 0, 0, 0, 0, 0, 0, 0};
#if ATTN_SIDE
          SideConv side; side.init(args.in[11], args.in[12], args.in[13], (unsigned char*)(ws + WS_WGU), (unsigned char*)(ws + WS_WD), F.lds + RING_OFF + attn8::LDS_SIDE + F.wave * 8192, F.vcu * NWAVES + F.wave, F.G * NWAVES);
#else
          SideNone side;
#endif
          const bool split10 = P1_ALL && P1_CONV > 0 && F.G == 256 && F.G > P1_CONV;
          const int NCG = split10 ? 32 - P10_HELP : 32, g10 = F.vcu >> 5, l10 = F.vcu & 31;
          if (F.G == 256) {
            if (l10 < NCG) for (int j = l10; j < 256; j += NCG) {
              const int b = g10, h = (j >> 6) * 4 + ((j >> 4) & 3), qb = j & 15;
              const int j2 = j + NCG; const bool hn = j2 < 256; const int h2 = (j2 >> 6) * 4 + ((j2 >> 4) & 3), qb2 = j2 & 15;
              attn8::attn_unit<8>(side, b, h, qb, j == l10, hn, b, h2, qb2, qcarry, (const unsigned char*)QB_, (const unsigned char*)KB_, (const unsigned char*)VB_, (attn8::bf16*)OB_, (char*)lds + RING_OFF, att_sc);
            }
          } else
          for (int i = 0; ; ++i) {
            const int L = i * F.G + F.vcu; if (L >= BATCH * 16 * 16) break;
            const int rnd = L >> 8, w = L & 255, b = w >> 5, l = w & 31, kvh = rnd >> 1, j = (rnd & 1) * 32 + l, h = kvh * 4 + (j >> 4), qb = j & 15;
            const int L2 = L + F.G; const bool hn = L2 < BATCH * 16 * 16;
            const int rnd2 = L2 >> 8, w2 = L2 & 255, b2 = w2 >> 5, l2 = w2 & 31, kvh2 = rnd2 >> 1, j2 = (rnd2 & 1) * 32 + l2, h2 = kvh2 * 4 + (j2 >> 4), qb2 = j2 & 15;
            attn8::attn_unit<8>(side, b, h, qb, i == 0, hn, b2, h2, qb2, qcarry, (const unsigned char*)QB_, (const unsigned char*)KB_, (const unsigned char*)VB_, (attn8::bf16*)OB_, (char*)lds + RING_OFF, att_sc);
          }
          if (split10) convert_dynamic(F, CW_CONV2, 2 * TR8_PER_LAYER / 8 - P10_PANELS, P10_PANELS, args.in[11], args.in[12], args.in[13], (unsigned char*)(ws + WS_WGU), (unsigned char*)(ws + WS_WD));
#if ATTN_SIDE
          side.flush(F.lane);
#endif
        }
#else
        for (int i = 0; ; ++i) {
            const int L = i * F.G + F.vcu; if (L >= BATCH * 16 * 16) break;
            const int rnd = L >> 8, w = L & 255, b = w >> 5, l = w & 31, kvh = rnd >> 1, j = (rnd & 1) * 32 + l, h = kvh * 4 + (j >> 4), qb = j & 15;
            attn_body::attn_unit<8>(b, h, qb, (const attn_body::bf16*)QB_, (const attn_body::bf16*)KB_, (const attn_body::bf16*)VB_, (attn_body::bf16*)OB_, (char*)lds + RING_OFF);
        }
#endif
    });
    SEAM(10);
#if ATTN_FP8
    RUNPHASE(11, {
        pg8::Gemm g{OB_, ws + WS_WO, D, nullptr, attn8::E8_O, E8_W, E8_W}; pg8::StaticOrder S; S.init(T, D, F.G, (int)blockIdx.x);
        pg8::EpiBf16Res<false> E{H, H, D};
        pg8::gemm_phase<pg8::EpiBf16Res<false>, pg8::StaticOrder, false, true>(F.lds + RING_OFF, g, S, E);
    });
#else
    RUNPHASE(11, {
        pg8::Gemm g{OB_, (const bf16*)(ws + WS_WO), D, nullptr, 0, 0, 0}; pg8::StaticOrder S; S.init(T, D, F.G, (int)blockIdx.x);
        pg8::EpiBf16Res<false> E{H, H, D};
        pg8::gemm_phase<pg8::EpiBf16Res<false>, pg8::StaticOrder, false>(F.lds + RING_OFF, g, S, E);
    });
#endif
    SEAM(11);
    MOE_BLOCK(1, 12);
#undef IN
#undef SEAM
}

extern "C" void kernel_launch(void* const* d_in, const int* in_sizes, int n_in, void* d_out, int out_size, void* d_ws, size_t ws_size, hipStream_t stream) {
    static int grid = 0;
    if (grid == 0) {
        if (n_in != 15 || in_sizes[0] != T * D || out_size != T * D || ws_size < WS_END) { fprintf(stderr, "kernel_launch: unexpected shapes (n_in %d, in0 %d, out %d, ws %zu); nothing launched\n", n_in, n_in > 0 ? in_sizes[0] : -1, out_size, ws_size); grid = -1; return; }
        int dev = 0, cus = 0, per_cu = 0;
        if (hipGetDevice(&dev) != hipSuccess || hipDeviceGetAttribute(&cus, hipDeviceAttributeMultiprocessorCount, dev) != hipSuccess) { grid = -1; return; }
        if (hipFuncSetAttribute((const void*)skel_fwd, hipFuncAttributeMaxDynamicSharedMemorySize, LDS_BYTES) != hipSuccess) { fprintf(stderr, "kernel_launch: hipFuncSetAttribute failed\n"); grid = -1; return; }
        if (hipOccupancyMaxActiveBlocksPerMultiprocessor(&per_cu, (const void*)skel_fwd, NWAVES * 64, LDS_BYTES) != hipSuccess || per_cu < 1)
            fprintf(stderr, "kernel_launch: note: occupancy query reports %d workgroups per CU\n", per_cu);
        (void)hipGetLastError();
        grid = cus;
    }
    if (grid < 0) return;
    if (hipMemsetAsync((char*)d_ws + WS_CTL, 0, CTL_ZERO_BYTES, stream) != hipSuccess) { fprintf(stderr, "kernel_launch: hipMemsetAsync failed\n"); return; }
    Args a{};
    for (int i = 0; i < 15; ++i) a.in[i] = (const float*)d_in[i];
    a.out = (float*)d_out; a.ws = (unsigned char*)d_ws;
    if (N_LAUNCHES == 1) {
        a.ph_lo = 0; a.ph_hi = N_PHASES;
        hipLaunchKernelGGL(skel_fwd, dim3(grid), dim3(NWAVES * 64), LDS_BYTES, stream, a);
    } else {
        for (int p = 0; p < N_PHASES; ++p) { a.ph_lo = p; a.ph_hi = p + 1; hipLaunchKernelGGL(skel_fwd, dim3(grid), dim3(NWAVES * 64), LDS_BYTES, stream, a); }
    }
    const hipError_t le = hipPeekAtLastError();
    if (le != hipSuccess) fprintf(stderr, "kernel_launch: launch failed: %s\n", hipGetErrorName(le));
}
```
